# Optimizing an MI355X kernel written in HIP

```python
import jax
import jax.numpy as jnp
from jax import lax
import numpy as np

D_MODEL = 2048
BATCH = 1
SEQ = 8192
DEPTH = 4

CTX_LEN = 256
GRID_W = 64
N_MIXERS = 2
N_S5_LAYERS = (DEPTH + 1) // 2
N_HGRN_LAYERS = DEPTH // 2
N_DIR = 2
EXPAND = 2
D_INNER = EXPAND * D_MODEL
S5_GROUP = 16
S5_GROUPS = D_INNER // S5_GROUP
S5_STATE = 64
S5_CHUNK = 128
S5_DT_MIN = 0.001
S5_DT_MAX = 0.1
HGRN_DK = 128
HGRN_DV = 128
HGRN_HEADS = D_INNER // HGRN_DV
HGRN_CHUNK = 64
EPS = 1e-6

kernel_name = 'hybrid_s5_hgrn2_prefix_dit_trunk'


def rmsnorm(x, gain):
    xf = x.astype(jnp.float32)
    inv = lax.rsqrt(jnp.mean(xf * xf, axis=-1, keepdims=True) + EPS)
    return (xf * inv).astype(x.dtype) * gain


def adaln(cond, w, b):
    mod = jax.nn.silu(cond) @ w + b
    return jnp.split(mod, 3, axis=-1)


def to_col_major(t, rows):
    b, l, d = t.shape
    return t.reshape(b, rows, GRID_W, d).transpose(0, 2, 1, 3).reshape(b, l, d)


def from_col_major(t, rows):
    b, l, d = t.shape
    return t.reshape(b, GRID_W, rows, d).transpose(0, 2, 1, 3).reshape(b, l, d)


def flip_seq(t):
    return jnp.flip(t, axis=1)


def same_order(t):
    return t


def s5_discretize(lam_re, lam_im, log_dt, b_re, b_im):
    lam_re, lam_im, log_dt, b_re, b_im = (t.astype(jnp.float32) for t in (lam_re, lam_im, log_dt, b_re, b_im))
    dt = jnp.exp(log_dt)[:, None]
    mag = jnp.exp(lam_re * dt)
    ar = mag * jnp.cos(lam_im * dt)
    ai = mag * jnp.sin(lam_im * dt)
    den = lam_re * lam_re + lam_im * lam_im
    qr = ((ar - 1.0) * lam_re + ai * lam_im) / den
    qi = (ai * lam_re - (ar - 1.0) * lam_im) / den
    bbr = qr[..., None] * b_re - qi[..., None] * b_im
    bbi = qr[..., None] * b_im + qi[..., None] * b_re
    return ar, ai, bbr, bbi


def s5_combine(e1, e2):
    ar1, ai1, br1, bi1 = e1
    ar2, ai2, br2, bi2 = e2
    return (ar2 * ar1 - ai2 * ai1, ar2 * ai1 + ai2 * ar1,
            ar2 * br1 - ai2 * bi1 + br2, ar2 * bi1 + ai2 * br1 + bi2)


def s5_scan(u, ar, ai, bbr, bbi, cr, ci, h0r, h0i, with_output):
    bsz, l = u.shape[:2]
    n = l // S5_CHUNK
    ub = u.reshape(bsz, n, S5_CHUNK, S5_GROUPS, S5_GROUP).transpose(1, 0, 2, 3, 4)
    a_shape = (bsz, S5_CHUNK, S5_GROUPS, S5_STATE)
    a_r = jnp.broadcast_to(ar, a_shape)
    a_i = jnp.broadcast_to(ai, a_shape)

    def step(carry, u_blk):
        hr, hi = carry
        bu_r = jnp.einsum('btgc,gpc->btgp', u_blk, bbr)
        bu_i = jnp.einsum('btgc,gpc->btgp', u_blk, bbi)
        pw_r, pw_i, s_r, s_i = lax.associative_scan(s5_combine, (a_r, a_i, bu_r, bu_i), axis=1)
        h_r = pw_r * hr[:, None] - pw_i * hi[:, None] + s_r
        h_i = pw_r * hi[:, None] + pw_i * hr[:, None] + s_i
        new = (h_r[:, -1], h_i[:, -1])
        if not with_output:
            return new, None
        y = jnp.einsum('btgp,gcp->btgc', h_r, cr) - jnp.einsum('btgp,gcp->btgc', h_i, ci)
        return new, y

    (hr, hi), ys = lax.scan(step, (h0r, h0i), ub)
    if not with_output:
        return None, hr, hi
    return ys.transpose(1, 0, 2, 3, 4).reshape(bsz, l, S5_GROUPS, S5_GROUP), hr, hi


def s5_branch(hx, hc, w_in, lam_re, lam_im, log_dt, b_re, b_im, c_re, c_im,
              d_skip, w_glu, b_glu, w_out, need_ctx):
    bsz = hx.shape[0]
    ux, zx = jnp.split(hx @ w_in, 2, axis=-1)
    pc = hc @ (w_in if need_ctx else w_in[:, :D_INNER])
    uc = pc[..., :D_INNER]

    def groups(t):
        return t.astype(jnp.float32).reshape(t.shape[0], t.shape[1], S5_GROUPS, S5_GROUP)

    gx, gc = groups(ux), groups(uc)
    zeros = jnp.zeros((bsz, S5_GROUPS, S5_STATE), jnp.float32)
    yx, yc = 0.0, 0.0
    for d in range(N_DIR):
        order = flip_seq if d == 1 else same_order
        ar, ai, bbr, bbi = s5_discretize(lam_re[d], lam_im[d], log_dt[d], b_re[d], b_im[d])
        cr, ci = c_re[d].astype(jnp.float32), c_im[d].astype(jnp.float32)
        y_c, hr, hi = s5_scan(order(gc), ar, ai, bbr, bbi, cr, ci, zeros, zeros, need_ctx)
        y_x, _, _ = s5_scan(order(gx), ar, ai, bbr, bbi, cr, ci, hr, hi, True)
        yx = yx + order(y_x)
        if need_ctx:
            yc = yc + order(y_c)

    def finish(y, u, z):
        y = y.reshape(u.shape).astype(u.dtype) + d_skip * u
        y = jax.nn.gelu(y, approximate=False)
        y = y * jax.nn.sigmoid(y @ w_glu + b_glu)
        return (y * jax.nn.silu(z)) @ w_out

    ox = finish(yx, ux, zx)
    oc = finish(yc, uc, pc[..., D_INNER:]) if need_ctx else None
    return ox, oc


def hgrn_lower_bound(lb_raw, j):
    p = jax.nn.softmax(lb_raw.astype(jnp.float32), axis=0)
    return jnp.cumsum(p, axis=0)[j] - p[0]


def hgrn_heads(t):
    return t.astype(jnp.float32).reshape(t.shape[0], t.shape[1], HGRN_HEADS, -1)


def hgrn_forget(f_raw, lb):
    lbh = lb.reshape(HGRN_HEADS, HGRN_DK)
    g = jnp.logaddexp(jnp.log(lbh), jnp.log1p(-lbh) + jax.nn.log_sigmoid(hgrn_heads(f_raw)))
    return g, -jnp.expm1(g)


def hgrn2_scan(k, v, g, s0, q=None):
    bsz, l = k.shape[:2]
    n = l // HGRN_CHUNK

    def blocks(t):
        return t.reshape(bsz, n, HGRN_CHUNK, HGRN_HEADS, t.shape[-1]).transpose(1, 0, 3, 2, 4)

    kb, vb = blocks(k), blocks(v)
    bb = jnp.cumsum(blocks(g), axis=3)
    lower = jnp.tril(jnp.ones((HGRN_CHUNK, HGRN_CHUNK), dtype=bool))[:, :, None]

    def step(s, blk):
        kc, vc, bc = blk[0], blk[1], blk[2]
        b_last = bc[:, :, -1, :]
        s_new = (jnp.exp(b_last)[..., None] * s
                 + jnp.einsum('bhsd,bhsv->bhdv', kc * jnp.exp(b_last[:, :, None] - bc), vc))
        if q is None:
            return s_new, None
        qc = blk[3]
        o_inter = jnp.einsum('bhtd,bhdv->bhtv', qc * jnp.exp(bc), s)
        decay = jnp.exp(jnp.where(lower, bc[:, :, :, None, :] - bc[:, :, None, :, :], -jnp.inf))
        scores = jnp.sum(qc[:, :, :, None, :] * kc[:, :, None, :, :] * decay, axis=-1)
        return s_new, o_inter + jnp.einsum('bhts,bhsv->bhtv', scores, vc)

    xs = (kb, vb, bb) if q is None else (kb, vb, bb, blocks(q))
    s_fin, ob = lax.scan(step, s0, xs)
    if q is None:
        return None, s_fin
    return ob.transpose(1, 0, 3, 2, 4).reshape(bsz, l, HGRN_HEADS, HGRN_DV), s_fin


def hgrn2_branch(hx, hc, w_in, lb_raw, o_norm, w_out, j, need_ctx):
    bsz = hx.shape[0]
    ix, f_fx, f_bx, qx, zx = jnp.split(hx @ w_in, 5, axis=-1)
    pc = hc @ (w_in if need_ctx else w_in[:, :3 * D_INNER])
    ic, f_fc, f_bc = pc[..., :D_INNER], pc[..., D_INNER:2 * D_INNER], pc[..., 2 * D_INNER:3 * D_INNER]
    v_x, v_c = hgrn_heads(ix), hgrn_heads(ic)
    q_x = hgrn_heads(jax.nn.silu(qx))
    q_c = hgrn_heads(jax.nn.silu(pc[..., 3 * D_INNER:4 * D_INNER])) if need_ctx else None
    s0 = jnp.zeros((bsz, HGRN_HEADS, HGRN_DK, HGRN_DV), jnp.float32)
    ox, oc = 0.0, 0.0
    for d, (f_x, f_c) in enumerate(((f_fx, f_fc), (f_bx, f_bc))):
        order = flip_seq if d == 1 else same_order
        lb = hgrn_lower_bound(lb_raw[d], j)
        g_x, k_x = hgrn_forget(f_x, lb)
        g_c, k_c = hgrn_forget(f_c, lb)
        o_c, s_c = hgrn2_scan(order(k_c), order(v_c), order(g_c), s0,
                              order(q_c) if need_ctx else None)
        o_x, _ = hgrn2_scan(order(k_x), order(v_x), order(g_x), s_c, order(q_x))
        ox = ox + order(o_x)
        if need_ctx:
            oc = oc + order(o_c)

    def finish(o, z):
        o = rmsnorm(o, o_norm).reshape(z.shape).astype(z.dtype)
        return (o * jax.nn.silu(z)) @ w_out

    out_x = finish(ox, zx)
    out_c = finish(oc, pc[..., 4 * D_INNER:]) if need_ctx else None
    return out_x, out_c


def setup_inputs(seed: int = 0) -> dict:
    key = jax.random.key(seed)
    ks = jax.random.split(key, 24)
    f32 = jnp.float32

    def nrm(k, shape, std):
        return std * jax.random.normal(k, shape, f32)

    e = D_INNER
    s5_shape = (N_S5_LAYERS, N_DIR, S5_GROUPS, S5_STATE)
    n_idx = jnp.arange(S5_STATE, dtype=f32)
    log_lo, log_hi = float(np.log(S5_DT_MIN)), float(np.log(S5_DT_MAX))
    return {
        'x': nrm(ks[0], (BATCH, SEQ, D_MODEL), 1.0),
        'c': nrm(ks[1], (BATCH, D_MODEL), 1.0),
        'ctx': nrm(ks[2], (BATCH, CTX_LEN, D_MODEL), 1.0),
        'c_ctx': nrm(ks[3], (D_MODEL,), 1.0),
        'ada_w': nrm(ks[4], (DEPTH, D_MODEL, 3 * D_MODEL), 0.5 * D_MODEL ** -0.5),
        'ada_b': nrm(ks[5], (DEPTH, 3 * D_MODEL), 0.02),
        'norm_pre': 1.0 + nrm(ks[6], (DEPTH, D_MODEL), 0.05),
        'norm_post': 1.0 + nrm(ks[7], (DEPTH, D_MODEL), 0.05),
        's5_w_in': nrm(ks[8], (N_S5_LAYERS, D_MODEL, 2 * e), D_MODEL ** -0.5),
        's5_lam_re': -0.5 + nrm(ks[9], s5_shape, 0.01),
        's5_lam_im': jnp.pi * n_idx + nrm(ks[10], s5_shape, 0.01),
        's5_log_dt': jax.random.uniform(ks[11], (N_S5_LAYERS, N_DIR, S5_GROUPS), f32, log_lo, log_hi),
        's5_b_re': nrm(ks[12], s5_shape + (S5_GROUP,), (2 * S5_GROUP) ** -0.5),
        's5_b_im': nrm(ks[13], s5_shape + (S5_GROUP,), (2 * S5_GROUP) ** -0.5),
        's5_c_re': nrm(ks[14], (N_S5_LAYERS, N_DIR, S5_GROUPS, S5_GROUP, S5_STATE), S5_STATE ** -0.5),
        's5_c_im': nrm(ks[15], (N_S5_LAYERS, N_DIR, S5_GROUPS, S5_GROUP, S5_STATE), S5_STATE ** -0.5),
        's5_d': nrm(ks[16], (N_S5_LAYERS, e), 1.0),
        's5_w_glu': nrm(ks[17], (N_S5_LAYERS, e, e), e ** -0.5),
        's5_b_glu': nrm(ks[18], (N_S5_LAYERS, e), 0.02),
        's5_w_out': nrm(ks[19], (N_S5_LAYERS, e, D_MODEL), e ** -0.5),
        'hgrn_w_in': nrm(ks[20], (N_HGRN_LAYERS, D_MODEL, 5 * e), D_MODEL ** -0.5),
        'hgrn_lb': nrm(ks[21], (N_DIR, N_HGRN_LAYERS, e), 0.5),
        'hgrn_norm': 1.0 + nrm(ks[22], (N_HGRN_LAYERS, HGRN_HEADS, HGRN_DV), 0.05),
        'hgrn_w_out': nrm(ks[23], (N_HGRN_LAYERS, e, D_MODEL), e ** -0.5),
    }


def reference(x, c, ctx, c_ctx, ada_w, ada_b, norm_pre, norm_post,
              s5_w_in, s5_lam_re, s5_lam_im, s5_log_dt, s5_b_re, s5_b_im,
              s5_c_re, s5_c_im, s5_d, s5_w_glu, s5_b_glu, s5_w_out,
              hgrn_w_in, hgrn_lb, hgrn_norm, hgrn_w_out):
    rows = x.shape[1] // GRID_W
    xc = ctx
    for i in range(DEPTH):
        need_ctx = i < DEPTH - 1
        j = i // N_MIXERS
        shift_x, scale_x, gate_x = adaln(c, ada_w[i], ada_b[i])
        shift_c, scale_c, gate_c = adaln(c_ctx, ada_w[i], ada_b[i])
        hx = rmsnorm(x, norm_pre[i]) * (1.0 + scale_x[:, None]) + shift_x[:, None]
        hc = rmsnorm(xc, norm_pre[i]) * (1.0 + scale_c) + shift_c
        col_major = j % 2 == 1
        if col_major:
            hx = to_col_major(hx, rows)
        if i % N_MIXERS == 0:
            ox, oc = s5_branch(hx, hc, s5_w_in[j], s5_lam_re[j], s5_lam_im[j], s5_log_dt[j],
                               s5_b_re[j], s5_b_im[j], s5_c_re[j], s5_c_im[j], s5_d[j],
                               s5_w_glu[j], s5_b_glu[j], s5_w_out[j], need_ctx)
        else:
            ox, oc = hgrn2_branch(hx, hc, hgrn_w_in[j], hgrn_lb, hgrn_norm[j], hgrn_w_out[j],
                                  j, need_ctx)
        if col_major:
            ox = from_col_major(ox, rows)
        x = x + gate_x[:, None] * rmsnorm(ox, norm_post[i])
        if need_ctx:
            xc = xc + gate_c * rmsnorm(oc, norm_post[i])
    return x
```

```cpp
#include <hip/hip_runtime.h>
#include <hip/hip_cooperative_groups.h>
#include <cstdio>
namespace cg = cooperative_groups;

#ifndef COOP
#define COOP 1
#endif

typedef unsigned short bf16_t;
typedef short bf16x8 __attribute__((ext_vector_type(8)));
typedef float f32x4 __attribute__((ext_vector_type(4)));
typedef unsigned short us4 __attribute__((ext_vector_type(4)));
typedef unsigned short us8 __attribute__((ext_vector_type(8)));
typedef unsigned u32x4 __attribute__((ext_vector_type(4)));

#define DM 2048
#define SEQL 8192
#define CTXL 256
#define MROWS 8448
#define EI 4096
#define NTHREADS 512
#define LDS_BYTES 149776

extern __shared__ __attribute__((aligned(16))) unsigned char g_smem[];

typedef __bf16 bf16v2_t __attribute__((ext_vector_type(2)));
typedef float f32x2_t __attribute__((ext_vector_type(2)));
__device__ __forceinline__ unsigned cvt_pk_bf16(float lo, float hi) { const f32x2_t v = {lo, hi}; return __builtin_bit_cast(unsigned, __builtin_convertvector(v, bf16v2_t)); }
__device__ __forceinline__ bf16_t f2bf(float f) { return (bf16_t)(cvt_pk_bf16(f, f) & 0xffffu); }
__device__ __forceinline__ float bf2f(bf16_t h) { return __uint_as_float(((unsigned)h) << 16); }
__device__ __forceinline__ float sigmoidf_(float x) { return 1.0f / (1.0f + __expf(-x)); }

constexpr size_t SZ_WS5IN = (size_t)8192 * 2048 * 2;
constexpr size_t SZ_WGLU = (size_t)4096 * 4096 * 2;
constexpr size_t SZ_WOUT = (size_t)2048 * 4096 * 2;
constexpr size_t SZ_WHIN = (size_t)20480 * 2048 * 2;
constexpr size_t OFF_WS5IN = 0;
constexpr size_t OFF_WGLU = OFF_WS5IN + 2 * SZ_WS5IN;
constexpr size_t OFF_WS5OUT = OFF_WGLU + 2 * SZ_WGLU;
constexpr size_t OFF_WHIN = OFF_WS5OUT + 2 * SZ_WOUT;
constexpr size_t OFF_WHOUT = OFF_WHIN + 2 * SZ_WHIN;
constexpr size_t OFF_MOD = OFF_WHOUT + 2 * SZ_WOUT;
constexpr size_t OFF_XCUR = OFF_MOD + 4 * 2 * 6144 * 4;
constexpr size_t OFF_HX = OFF_XCUR + (size_t)MROWS * DM * 4;
constexpr size_t OFF_OX = OFF_HX + (size_t)MROWS * DM * 2;
constexpr size_t OFF_P = OFF_OX + (size_t)MROWS * DM * 4;
constexpr size_t OFF_R = OFF_P + (size_t)MROWS * 20480 * 2;
constexpr size_t OFF_YG = OFF_R;
constexpr size_t OFF_V = OFF_YG + (size_t)MROWS * EI * 2;
constexpr size_t OFF_S5SCR = OFF_V + (size_t)MROWS * EI * 2;
constexpr size_t S5_S = 0;
constexpr size_t S5_H = S5_S + 270336;
constexpr size_t S5_PER = S5_H + 135168;
constexpr size_t OFF_OFB = OFF_R;
constexpr size_t OFF_QB = OFF_OFB + (size_t)2 * MROWS * EI * 2;
constexpr size_t OFF_VT = OFF_QB + (size_t)2 * MROWS * EI * 2;
constexpr size_t OFF_DEC = OFF_VT + (size_t)MROWS * EI * 2;
constexpr size_t OFF_OH = OFF_DEC + (size_t)132 * 32 * 2 * 128 * 4;
constexpr size_t OFF_BAR = OFF_OH + (size_t)MROWS * EI * 2;
constexpr size_t WS_TOTAL = OFF_BAR + 16384;
static_assert(WS_TOTAL <= (size_t)4 * 2 * 2048 * 20480 * 4, "workspace overflow");

#define GAS __attribute__((address_space(1)))
struct Params {
  const float GAS *x, *c, *ctx, *cctx, *ada_w, *ada_b, *norm_pre, *norm_post;
  const float GAS *s5_w_in, *s5_lam_re, *s5_lam_im, *s5_log_dt, *s5_b_re, *s5_b_im, *s5_c_re, *s5_c_im, *s5_d, *s5_w_glu, *s5_b_glu, *s5_w_out;
  const float GAS *hgrn_w_in, *hgrn_lb, *hgrn_norm, *hgrn_w_out;
  float GAS* out;
  unsigned char GAS* ws;
};

template <class T> __device__ __forceinline__ T* G(GAS T* q) { return (T*)q; }

__device__ __forceinline__ void conv_desc(const Params& p, int T, const float*& src, bf16_t*& dst, int& K, int& N, int& k0, int& n0) {
  int j = T / 22528, r = T % 22528;
  if (r < 4096) { src = G(p.s5_w_in) + (size_t)j * 2048 * 8192; dst = (bf16_t*)(G(p.ws) + OFF_WS5IN + j * SZ_WS5IN); K = 2048; N = 8192; }
  else if (r < 8192) { r -= 4096; src = G(p.s5_w_glu) + (size_t)j * 4096 * 4096; dst = (bf16_t*)(G(p.ws) + OFF_WGLU + j * SZ_WGLU); K = 4096; N = 4096; }
  else if (r < 10240) { r -= 8192; src = G(p.s5_w_out) + (size_t)j * 4096 * 2048; dst = (bf16_t*)(G(p.ws) + OFF_WS5OUT + j * SZ_WOUT); K = 4096; N = 2048; }
  else if (r < 20480) { r -= 10240; src = G(p.hgrn_w_in) + (size_t)j * 2048 * 20480; dst = (bf16_t*)(G(p.ws) + OFF_WHIN + j * SZ_WHIN); K = 2048; N = 20480; }
  else { r -= 20480; src = G(p.hgrn_w_out) + (size_t)j * 4096 * 2048; dst = (bf16_t*)(G(p.ws) + OFF_WHOUT + j * SZ_WOUT); K = 4096; N = 2048; }
  const int nNt = N >> 6;
  k0 = (r / nNt) << 6; n0 = (r % nNt) << 6;
}
__device__ void convert_phase(const Params& p, int bid, int nblk, int tidx) {
  float* tile = (float*)g_smem;
  const int tid = tidx;
  const int total = 45056;
  const int kk = tid >> 4, n4 = tid & 15;
  f32x4 nv0 = (f32x4){0.f, 0.f, 0.f, 0.f}, nv1 = nv0;
  if (bid < total) {
    const float* src; bf16_t* dst; int K, N, k0, n0;
    conv_desc(p, bid, src, dst, K, N, k0, n0);
    nv0 = __builtin_nontemporal_load((const f32x4*)(src + (size_t)(k0 + kk) * N + n0 + n4 * 4));
    nv1 = __builtin_nontemporal_load((const f32x4*)(src + (size_t)(k0 + 32 + kk) * N + n0 + n4 * 4));
  }
#pragma unroll 1
  for (int T = bid; T < total; T += nblk) {
    const float* src; bf16_t* dst; int K, N, k0, n0;
    conv_desc(p, T, src, dst, K, N, k0, n0);
    {
      const f32x4 v0 = nv0, v1 = nv1;
      tile[kk * 65 + n4 * 4 + 0] = v0[0]; tile[kk * 65 + n4 * 4 + 1] = v0[1]; tile[kk * 65 + n4 * 4 + 2] = v0[2]; tile[kk * 65 + n4 * 4 + 3] = v0[3];
      tile[(32 + kk) * 65 + n4 * 4 + 0] = v1[0]; tile[(32 + kk) * 65 + n4 * 4 + 1] = v1[1]; tile[(32 + kk) * 65 + n4 * 4 + 2] = v1[2]; tile[(32 + kk) * 65 + n4 * 4 + 3] = v1[3];
    }
    if (T + nblk < total) {
      const float* s2; bf16_t* d2; int K2, N2, k2, n2;
      conv_desc(p, T + nblk, s2, d2, K2, N2, k2, n2);
      nv0 = __builtin_nontemporal_load((const f32x4*)(s2 + (size_t)(k2 + kk) * N2 + n2 + n4 * 4));
      nv1 = __builtin_nontemporal_load((const f32x4*)(s2 + (size_t)(k2 + 32 + kk) * N2 + n2 + n4 * 4));
    }
    asm volatile("s_waitcnt lgkmcnt(0)" ::: "memory"); __builtin_amdgcn_s_barrier(); asm volatile("" ::: "memory");
    {
      const int n = tid >> 3, k8 = tid & 7;
      us8 o;
#pragma unroll
      for (int i = 0; i < 8; ++i) o[i] = f2bf(tile[(k8 * 8 + i) * 65 + n]);
      *(us8*)(dst + (size_t)(n0 + n) * K + k0 + k8 * 8) = o;
    }
    asm volatile("s_waitcnt lgkmcnt(0)" ::: "memory"); __builtin_amdgcn_s_barrier(); asm volatile("" ::: "memory");
  }
  __syncthreads();
}

__device__ void adaln_phase(const Params& p, int bid, int nblk, int tidx) {
  float* sc = (float*)g_smem;
  float* red = sc + 4096;
  float* mod = (float*)(G(p.ws) + OFF_MOD);
  const int tid = tidx;
  bool inited = false;
  for (int it = bid; it < 384; it += nblk) {
    if (!inited) {
      for (int k = tid; k < 2048; k += NTHREADS) {
        float a = G(p.c)[k], b = G(p.cctx)[k];
        sc[k] = a * sigmoidf_(a); sc[2048 + k] = b * sigmoidf_(b);
      }
      inited = true;
      __syncthreads();
    }
    const int i = it / 96, col0 = (it % 96) * 64;
    const int cg4 = tid & 15, ks = tid >> 4;
    float acc[8];
#pragma unroll
    for (int e = 0; e < 8; ++e) acc[e] = 0.f;
    const float* wp = G(p.ada_w) + (size_t)i * 2048 * 6144 + col0 + cg4 * 4;
#pragma unroll 4
    for (int kk = 0; kk < 64; ++kk) {
      const int k = kk * 32 + ks;
      f32x4 w = __builtin_nontemporal_load((const f32x4*)(wp + (size_t)k * 6144));
      const float s0 = sc[k], s1 = sc[2048 + k];
#pragma unroll
      for (int e = 0; e < 4; ++e) { acc[e] += w[e] * s0; acc[4 + e] += w[e] * s1; }
    }
#pragma unroll
    for (int e = 0; e < 8; ++e) red[(ks * 16 + cg4) * 8 + e] = acc[e];
    __syncthreads();
    if (tid < 128) {
      const int c4 = tid >> 3, v = tid & 7;
      float s = 0.f;
      for (int q = 0; q < 32; ++q) s += red[(q * 16 + c4) * 8 + v];
      const int which = v >> 2, col = col0 + c4 * 4 + (v & 3);
      mod[(i * 2 + which) * 6144 + col] = s + G(p.ada_b)[i * 6144 + col];
    }
    __syncthreads();
  }
}

__device__ __forceinline__ float wave_sum(float v) {
#pragma unroll
  for (int o = 32; o > 0; o >>= 1) v += __shfl_xor(v, o);
  return v;
}
__device__ __forceinline__ int perm_row(int layer, int l) { return (layer >= 2) ? ((l & 63) * 128 + (l >> 6)) : l; }

__device__ void norm_phase(const Params& p, int i, int bid, int nblk, int tidx) {
  const int tid = tidx, lane = tid & 63, wid = tid >> 6;
  const float* mod = (const float*)(G(p.ws) + OFF_MOD);
  float* xcur = (float*)(G(p.ws) + OFF_XCUR);
  const bf16_t* ox = (const bf16_t*)(G(p.ws) + OFF_OX);
  bf16_t* hx = (bf16_t*)(G(p.ws) + OFF_HX);
  for (int r = bid * 8 + wid; r < MROWS; r += nblk * 8) {
    const bool isctx = r < CTXL;
    const int l = r - CTXL;
    if (i == 4 && isctx) continue;
    const int which = isctx ? 1 : 0;
    const float* xs = (i <= 1) ? (isctx ? G(p.ctx) + (size_t)r * DM : G(p.x) + (size_t)l * DM) : xcur + (size_t)r * DM;
    f32x4 xv[8];
#pragma unroll
    for (int q = 0; q < 8; ++q) xv[q] = *(const f32x4*)(xs + (q * 64 + lane) * 4);
    if (i > 0) {
      const int orow = isctx ? r : CTXL + perm_row(i - 1, l);
      const bf16_t* os = ox + (size_t)orow * DM;
      f32x4 ov[8];
      float ss = 0.f;
#pragma unroll
      for (int q = 0; q < 8; ++q) {
        { const us4 t_ = *(const us4*)(os + (q * 64 + lane) * 4); ov[q] = (f32x4){bf2f(t_[0]), bf2f(t_[1]), bf2f(t_[2]), bf2f(t_[3])}; }
        ss += ov[q][0] * ov[q][0] + ov[q][1] * ov[q][1] + ov[q][2] * ov[q][2] + ov[q][3] * ov[q][3];
      }
      ss = wave_sum(ss);
      const float inv = rsqrtf(ss * (1.0f / DM) + 1e-6f);
      const float* gate = mod + ((i - 1) * 2 + which) * 6144 + 4096;
      const float* np = G(p.norm_post) + (i - 1) * DM;
#pragma unroll
      for (int q = 0; q < 8; ++q) {
        const int col = (q * 64 + lane) * 4;
        f32x4 gv = *(const f32x4*)(gate + col), nv = *(const f32x4*)(np + col);
#pragma unroll
        for (int e = 0; e < 4; ++e) xv[q][e] += gv[e] * (ov[q][e] * inv * nv[e]);
      }
      float* xd = (i == 4) ? G(p.out) + (size_t)l * DM : xcur + (size_t)r * DM;
#pragma unroll
      for (int q = 0; q < 8; ++q) *(f32x4*)(xd + (q * 64 + lane) * 4) = xv[q];
    }
    if (i < 4) {
      float ss = 0.f;
#pragma unroll
      for (int q = 0; q < 8; ++q) ss += xv[q][0] * xv[q][0] + xv[q][1] * xv[q][1] + xv[q][2] * xv[q][2] + xv[q][3] * xv[q][3];
      ss = wave_sum(ss);
      const float inv = rsqrtf(ss * (1.0f / DM) + 1e-6f);
      const float* shift = mod + (i * 2 + which) * 6144;
      const float* scale = shift + 2048;
      const float* np = G(p.norm_pre) + i * DM;
      const int hrow = isctx ? r : CTXL + perm_row(i, l);
      bf16_t* hd = hx + (size_t)hrow * DM;
#pragma unroll
      for (int q = 0; q < 8; ++q) {
        const int col = (q * 64 + lane) * 4;
        f32x4 sh = *(const f32x4*)(shift + col), scv = *(const f32x4*)(scale + col), nv = *(const f32x4*)(np + col);
        us4 o;
#pragma unroll
        for (int e = 0; e < 4; ++e) o[e] = f2bf((xv[q][e] * inv) * nv[e] * (1.0f + scv[e]) + sh[e]);
        *(us4*)(hd + col) = o;
      }
    }
  }
}

constexpr int BM = 256, BK = 64, HALF = 128, NXCD = 8, WGM = 4, HT = HALF * BK;

__device__ __forceinline__ int lds_byte(int r, int c) {
  int st = (r >> 4) * 2 + (c >> 5), rr = r & 15, cc = c & 31, ob = rr * 64 + cc * 2;
  return st * 1024 + (ob ^ (((ob >> 9) & 1) << 5));
}
__device__ __forceinline__ void stage_rc(int b, int& R, int& C) {
  int st = b / 1024, sb = b % 1024, swz = sb ^ (((sb >> 9) & 1) << 5);
  R = (st >> 1) * 16 + swz / 64; C = (st & 1) * 32 + (swz % 64) / 2;
}

struct EpiAny {
  int mode; void* O; int ld; const bf16_t* yg; const bf16_t* z; int ldz; const float* bias;
  __device__ __forceinline__ void operator()(const f32x4 (&acc)[2][2][4][2], int brow, int bcol, int wr, int wc, int fr, int fq) const {
    if (mode == 0) {
      bf16_t* Ob = (bf16_t*)O;
      const int lane_ = fr + 16 * fq, wid_ = wr * 4 + wc;
      unsigned char __attribute__((address_space(3)))* tb = (unsigned char __attribute__((address_space(3)))*)g_smem + 131072 + wid_ * 2048;
#pragma unroll
      for (int ai = 0; ai < 2; ++ai)
#pragma unroll
        for (int bj = 0; bj < 2; ++bj)
#pragma unroll
          for (int hh = 0; hh < 2; ++hh) {
#pragma unroll
            for (int mm = 0; mm < 2; ++mm)
#pragma unroll
              for (int n = 0; n < 2; ++n) {
                const f32x4 v = acc[ai][bj][hh * 2 + mm][n];
                unsigned __attribute__((ext_vector_type(2))) o2;
                o2[0] = cvt_pk_bf16(v[0], v[1]); o2[1] = cvt_pk_bf16(v[2], v[3]);
                *(unsigned __attribute__((ext_vector_type(2))) __attribute__((address_space(3)))*)(tb + (mm * 16 + fr) * 64 + (((n * 16 + fq * 4) * 2) ^ (((fr >> 1) & 3) << 4))) = o2;
              }
#pragma unroll
            for (int ps = 0; ps < 2; ++ps) {
              const int rr = ps * 16 + (lane_ >> 2);
              const us8 o = *(const us8 __attribute__((address_space(3)))*)(tb + rr * 64 + (((lane_ & 3) * 16) ^ (((rr >> 1) & 3) << 4)));
              const int row = brow + ai * HALF + wr * 64 + hh * 32 + rr;
              const int col = bcol + bj * HALF + wc * 32 + (lane_ & 3) * 8;
              *(us8*)(Ob + (size_t)row * ld + col) = o;
            }
          }
    } else {
      const int lane_ = fr + 16 * fq, wid_ = wr * 4 + wc;
      unsigned char __attribute__((address_space(3)))* tb = (unsigned char __attribute__((address_space(3)))*)g_smem + 131072 + wid_ * 2048;
      const int rr = lane_ >> 2, g0 = (lane_ & 3) * 2;
#pragma unroll
      for (int ai = 0; ai < 2; ++ai)
#pragma unroll
        for (int bj = 0; bj < 2; ++bj)
#pragma unroll
          for (int m = 0; m < 4; ++m) {
#pragma unroll
            for (int n = 0; n < 2; ++n)
              *(f32x4 __attribute__((address_space(3)))*)(tb + fr * 128 + (((n * 4 + fq) ^ (fr & 7)) << 4)) = acc[ai][bj][m][n];
            const f32x4 s0 = *(const f32x4 __attribute__((address_space(3)))*)(tb + rr * 128 + (((g0) ^ (rr & 7)) << 4));
            const f32x4 s1 = *(const f32x4 __attribute__((address_space(3)))*)(tb + rr * 128 + (((g0 + 1) ^ (rr & 7)) << 4));
            const int row = brow + ai * HALF + wr * 64 + m * 16 + rr;
            const int col = bcol + bj * HALF + wc * 32 + (lane_ & 3) * 8;
            if (mode == 1) {
              float* op = (float*)O + (size_t)row * ld + col;
              *(f32x4*)op = s0; *(f32x4*)(op + 4) = s1;
            } else {
              const us8 yv = *(const us8*)(yg + (size_t)row * EI + col);
              const us8 zv = *(const us8*)(z + (size_t)row * ldz + col);
              const f32x4 b0 = *(const f32x4*)(bias + col), b1 = *(const f32x4*)(bias + col + 4);
              u32x4 o;
#pragma unroll
              for (int e = 0; e < 4; ++e) {
                const float a0 = (e < 2 ? s0[2 * e] + b0[2 * e] : s1[2 * e - 4] + b1[2 * e - 4]);
                const float a1 = (e < 2 ? s0[2 * e + 1] + b0[2 * e + 1] : s1[2 * e - 3] + b1[2 * e - 3]);
                const float y0 = bf2f(yv[2 * e]), y1 = bf2f(yv[2 * e + 1]), z0 = bf2f(zv[2 * e]), z1 = bf2f(zv[2 * e + 1]);
                o[e] = cvt_pk_bf16(y0 * sigmoidf_(a0) * (z0 * sigmoidf_(z0)), y1 * sigmoidf_(a1) * (z1 * sigmoidf_(z1)));
              }
              *(u32x4*)((bf16_t*)O + (size_t)row * EI + col) = o;
            }
          }
    }
  }
};

#define LAS __attribute__((address_space(3)))
struct Unit { int pm, pn; };
struct TileOrder {
  int nM, nN, nwg, G, c;
  __device__ __forceinline__ bool next(int i, Unit& u) const {
    const long L = (long)i * G + c; if (L >= nwg) return false;
    int wgid = (int)L; { const int q = nwg / NXCD, r = nwg % NXCD, xcd = wgid % NXCD, off = wgid / NXCD; wgid = (xcd < r ? xcd * (q + 1) : r * (q + 1) + (xcd - r) * q) + off; }
    const int nig = WGM * nN, gid = wgid / nig, fm = gid * WGM, gsz = (nM - fm) < WGM ? (nM - fm) : WGM;
    u.pm = fm + ((wgid % nig) % gsz); u.pn = (wgid % nig) / gsz; return true;
  }
};
constexpr int HTB = HALF * BK * 2;

__device__ __forceinline__ EpiAny make_epi(const Params& p, int s, int is_s5, int j) {
  EpiAny e{};
  bf16_t* P = (bf16_t*)(G(p.ws) + OFF_P);
  if (s == 1) { e.mode = 0; e.O = P; e.ld = is_s5 ? 8192 : 20480; }
  else if (s == 3) { e.mode = 2; e.O = G(p.ws) + OFF_V; e.ld = EI; e.yg = (const bf16_t*)(G(p.ws) + OFF_YG); e.z = P + 4096; e.ldz = 8192; e.bias = G(p.s5_b_glu) + (size_t)j * EI; }
  else { e.mode = 0; e.O = G(p.ws) + OFF_OX; e.ld = DM; }
  return e;
}
__device__ __forceinline__ void gemm_phase(const bf16_t* __restrict__ A, const bf16_t* __restrict__ Bt, int M, int N, int K, const Params& p, int es, int eis5, int ej, int bid, int nblk, int tidx) {
  LAS unsigned char* lds = (LAS unsigned char*)g_smem;
  TileOrder S; S.nM = M / BM; S.nN = N / BM; S.nwg = S.nM * S.nN; S.G = nblk; S.c = bid;
  const int tid = tidx, wid = __builtin_amdgcn_readfirstlane(tid >> 6), lane = tid & 63, wr = wid >> 2, wc = wid & 3, fr = lane & 15, fq = lane >> 4;
  const int nt = K / BK;
  unsigned voffA[2];
#pragma unroll
  for (int i = 0; i < 2; ++i) { int R, C; stage_rc(tid * 16 + i * 8192, R, C); voffA[i] = (unsigned)(R * K + C) * 2u; }
  const size_t kstep = (size_t)(BK * 2);
  const size_t hstep = (size_t)HALF * K * 2;
  const size_t tstep = 2 * hstep;
  const unsigned ldsw = (unsigned)wid * 1024u;
  const int aoff = lds_byte(wr * 64 + fr, fq * 8), boff = lds_byte(wc * 32 + fr, fq * 8);
#define G_SA(b, h) (((b) * 2 + (h)) * HTB)
#define G_SB(b, h) ((4 + (b) * 2 + (h)) * HTB)
#define G_STAGE(bufoff, gbase) do { _Pragma("unroll") for (int _i = 0; _i < 2; ++_i) \
    __builtin_amdgcn_global_load_lds((const unsigned*)((const char*)(gbase) + voffA[_i]), (LAS unsigned*)(lds + (bufoff) + ldsw + _i * 8192), 16, 0, 0); } while (0)
#define G_LDA(dst, b, h) do { _Pragma("unroll") for (int m = 0; m < 4; ++m) _Pragma("unroll") for (int k = 0; k < 2; ++k) dst[m][k] = *(const LAS bf16x8*)(lds + G_SA(b, h) + aoff + m * 2048 + k * 1024); } while (0)
#define G_LDB(dst, b, h) do { _Pragma("unroll") for (int n = 0; n < 2; ++n) _Pragma("unroll") for (int k = 0; k < 2; ++k) dst[n][k] = *(const LAS bf16x8*)(lds + G_SB(b, h) + boff + n * 2048 + k * 1024); } while (0)
#define G_MMA(ai, bj, At_, Bt_) do { __builtin_amdgcn_s_setprio(1); _Pragma("unroll") for (int m = 0; m < 4; ++m) _Pragma("unroll") for (int n = 0; n < 2; ++n) _Pragma("unroll") for (int k = 0; k < 2; ++k) \
    acc[ai][bj][m][n] = __builtin_amdgcn_mfma_f32_16x16x32_bf16(Bt_[n][k], At_[m][k], acc[ai][bj][m][n], 0, 0, 0); __builtin_amdgcn_s_setprio(0); } while (0)
#define G_WAIT_V(n) asm volatile("s_waitcnt vmcnt(" #n ")" ::: "memory")
#define G_WAIT_L(n) asm volatile("s_waitcnt lgkmcnt(" #n ")" ::: "memory")
#define G_BAR __builtin_amdgcn_s_barrier()
#define G_SCHED __builtin_amdgcn_sched_barrier(0)
  Unit cur, nxt; int ui = 0;
  __syncthreads();
  if (!S.next(0, cur)) return;
  f32x4 acc[2][2][4][2];
#pragma unroll
  for (int a = 0; a < 2; ++a)
#pragma unroll
    for (int b = 0; b < 2; ++b)
#pragma unroll
      for (int m = 0; m < 4; ++m)
#pragma unroll
        for (int n = 0; n < 2; ++n) acc[a][b][m][n] = (f32x4){0.f, 0.f, 0.f, 0.f};
  bf16x8 At[4][2], B0[2][2], B1[2][2];
  const char* cA = (const char*)A + (size_t)cur.pm * tstep; const char* cB = (const char*)Bt + (size_t)cur.pn * tstep;
  G_STAGE(G_SB(0, 0), cB); G_STAGE(G_SA(0, 0), cA); G_STAGE(G_SB(0, 1), cB + hstep); G_STAGE(G_SA(0, 1), cA + hstep);
  if (wr == 1) G_BAR;
  G_WAIT_V(4); G_BAR;
  G_STAGE(G_SB(1, 0), cB + kstep); G_STAGE(G_SA(1, 0), cA + kstep); G_STAGE(G_SB(1, 1), cB + hstep + kstep);
  G_WAIT_V(6); G_BAR;
  for (;;) {
    const bool has_next = S.next(ui + 1, nxt);
    const char* nA = has_next ? (const char*)A + (size_t)nxt.pm * tstep : cA; const char* nB = has_next ? (const char*)Bt + (size_t)nxt.pn * tstep : cB;
    for (int t = 0; t < nt; t += 2) {
      const bool last = (t == nt - 2);
      const char* a1 = cA + (size_t)(t + 1) * kstep;
      const char* a2 = last ? nA : cA + (size_t)(t + 2) * kstep; const char* b2 = last ? nB : cB + (size_t)(t + 2) * kstep;
      const char* a3 = a2 + kstep; const char* b3 = b2 + kstep;
      G_LDB(B0, 0, 0); G_SCHED; G_LDA(At, 0, 0); G_STAGE(G_SA(1, 1), a1 + hstep);
      G_WAIT_L(8); G_BAR; G_WAIT_L(0); G_MMA(0, 0, At, B0); G_BAR; G_SCHED;
      G_LDB(B1, 0, 1); G_STAGE(G_SB(0, 0), b2);
      G_BAR; G_WAIT_L(0); G_MMA(0, 1, At, B1); G_BAR;
      G_LDA(At, 0, 1); G_STAGE(G_SA(0, 0), a2);
      G_BAR; G_WAIT_L(0); G_MMA(1, 0, At, B0); G_BAR; G_SCHED;
      G_STAGE(G_SB(0, 1), b2 + hstep);
      G_WAIT_V(6); G_BAR; G_MMA(1, 1, At, B1); G_BAR;
      G_LDB(B0, 1, 0); G_SCHED; G_LDA(At, 1, 0); G_STAGE(G_SA(0, 1), a2 + hstep);
      G_WAIT_L(8); G_BAR; G_WAIT_L(0); G_MMA(0, 0, At, B0); G_BAR; G_SCHED;
      G_LDB(B1, 1, 1); G_STAGE(G_SB(1, 0), b3);
      G_BAR; G_WAIT_L(0); G_MMA(0, 1, At, B1); G_BAR;
      G_LDA(At, 1, 1); G_STAGE(G_SA(1, 0), a3);
      G_BAR; G_WAIT_L(0); G_MMA(1, 0, At, B0); G_BAR; G_SCHED;
      G_STAGE(G_SB(1, 1), b3 + hstep);
      G_WAIT_V(6); G_BAR; G_MMA(1, 1, At, B1); G_BAR;
    }
    {
      int es_ = es; asm volatile("" : "+s"(es_));
      const EpiAny E = make_epi(p, es_, eis5, ej);
      E(acc, cur.pm * BM + (eis5 || es_ != 1 ? CTXL : 0), cur.pn * BM, wr, wc, fr, fq);
    }
    if (!has_next) break;
#pragma unroll
    for (int a = 0; a < 2; ++a)
#pragma unroll
      for (int b = 0; b < 2; ++b)
#pragma unroll
        for (int m = 0; m < 4; ++m)
#pragma unroll
          for (int n = 0; n < 2; ++n) acc[a][b][m][n] = (f32x4){0.f, 0.f, 0.f, 0.f};
    cur = nxt; cA = nA; cB = nB; ++ui;
  }
  G_WAIT_V(0);
  if (wr == 0) G_BAR;
  G_BAR;
#undef G_SA
#undef G_SB
#undef G_STAGE
#undef G_LDA
#undef G_LDB
#undef G_MMA
}

#define MFMA16(a, b, c) __builtin_amdgcn_mfma_f32_16x16x32_bf16(a, b, c, 0, 0, 0)
__device__ __forceinline__ void gemm_small_phase(const bf16_t* __restrict__ A, const bf16_t* __restrict__ Bt, int N, int K, const Params& p, int es, int eis5, int ej, int bid, int nblk, int tidx) {
  float* part = (float*)g_smem;
  const int tid = tidx, lane = tid & 63, wid = tid >> 6, fr = lane & 15, fq = lane >> 4;
  const int nsn = N >> 6;
  const int kw = K >> 3, nkb = kw >> 7;
#pragma unroll 1
  for (int u = bid; ; u += nblk) {
    const int b_ = u % nblk, k_ = u / nblk;
    int sm, sn;
    if ((nblk & 255) == 0) { const int b8 = b_ & 255; sm = (b8 >> 3) & 3; sn = (b8 & 7) + 8 * (b8 >> 5) + 64 * ((b_ >> 8) + (nblk >> 8) * k_); }
    else { sm = u & 3; sn = u >> 2; }
    if (sn >= nsn) { if ((nblk & 255) == 0 ? (64 * (nblk >> 8) * k_ >= nsn) : true) break; else continue; }
    f32x4 acc[4][4];
#pragma unroll
    for (int a = 0; a < 4; ++a)
#pragma unroll
      for (int b = 0; b < 4; ++b) acc[a][b] = (f32x4){0.f, 0.f, 0.f, 0.f};
    const bf16_t* ap = A + (size_t)(sm * 64 + (lane >> 2)) * K + wid * kw + (lane & 3) * 8;
    const bf16_t* bp = Bt + (size_t)(sn * 64 + (lane >> 2)) * K + wid * kw + (lane & 3) * 8;
    const int bsrc = (4 * fr + fq) * 4;
#pragma unroll 1
    for (int kb = 0; kb < nkb; ++kb) {
      bf16x8 af[4][4], bf[4][4];
      {
        u32x4 ra[4][4], rb[4][4];
#pragma unroll
        for (int ks = 0; ks < 4; ++ks)
#pragma unroll
          for (int i = 0; i < 4; ++i) {
            ra[ks][i] = *(const u32x4*)(ap + (size_t)i * 16 * K + kb * 128 + ks * 32);
            rb[ks][i] = *(const u32x4*)(bp + (size_t)i * 16 * K + kb * 128 + ks * 32);
          }
        __builtin_amdgcn_sched_barrier(0);
#pragma unroll
        for (int ks = 0; ks < 4; ++ks)
#pragma unroll
          for (int i = 0; i < 4; ++i) {
            u32x4 ta, tb;
#pragma unroll
            for (int w4 = 0; w4 < 4; ++w4) {
              ta[w4] = (unsigned)__builtin_amdgcn_ds_bpermute(bsrc, (int)ra[ks][i][w4]);
              tb[w4] = (unsigned)__builtin_amdgcn_ds_bpermute(bsrc, (int)rb[ks][i][w4]);
            }
            af[ks][i] = __builtin_bit_cast(bf16x8, ta); bf[ks][i] = __builtin_bit_cast(bf16x8, tb);
          }
      }
#pragma unroll
      for (int ks = 0; ks < 4; ++ks)
#pragma unroll
        for (int mi = 0; mi < 4; ++mi)
#pragma unroll
          for (int ni = 0; ni < 4; ++ni) acc[mi][ni] = MFMA16(bf[ks][ni], af[ks][mi], acc[mi][ni]);
    }
    __syncthreads();
#pragma unroll
    for (int mi = 0; mi < 4; ++mi)
#pragma unroll
      for (int ni = 0; ni < 4; ++ni) *(f32x4*)(part + (wid * 64 + mi * 16 + fr) * 68 + ni * 16 + fq * 4) = acc[mi][ni];
    __syncthreads();
    {
      const int rl = tid >> 3, c0 = (tid & 7) * 8;
      f32x4 s0 = (f32x4){0.f, 0.f, 0.f, 0.f}, s1 = s0;
#pragma unroll
      for (int w = 0; w < 8; ++w) { s0 += *(const f32x4*)(part + (w * 64 + rl) * 68 + c0); s1 += *(const f32x4*)(part + (w * 64 + rl) * 68 + c0 + 4); }
      const int row = sm * 64 + rl, col = sn * 64 + c0;
      bf16_t* Pp = (bf16_t*)(G(p.ws) + OFF_P);
      if (es == 1) {
        const int ld = eis5 ? 8192 : 20480;
        us8 o;
#pragma unroll
        for (int e = 0; e < 4; ++e) { o[e] = f2bf(s0[e]); o[4 + e] = f2bf(s1[e]); }
        *(us8*)(Pp + (size_t)row * ld + col) = o;
      } else if (es == 3) {
        const us8 yv = *(const us8*)((const bf16_t*)(G(p.ws) + OFF_YG) + (size_t)row * EI + col);
        const us8 zv = *(const us8*)(Pp + (size_t)row * 8192 + 4096 + col);
        const float* bias = G(p.s5_b_glu) + (size_t)ej * EI + col;
        const f32x4 b0 = *(const f32x4*)bias, b1 = *(const f32x4*)(bias + 4);
        us8 o;
#pragma unroll
        for (int e = 0; e < 8; ++e) {
          const float a = (e < 4 ? s0[e & 3] : s1[e & 3]) + (e < 4 ? b0[e & 3] : b1[e & 3]);
          const float y = bf2f(yv[e]), zz = bf2f(zv[e]);
          o[e] = f2bf(y * sigmoidf_(a) * (zz * sigmoidf_(zz)));
        }
        *(us8*)((bf16_t*)(G(p.ws) + OFF_V) + (size_t)row * EI + col) = o;
      } else {
        u32x4 o;
        o[0] = cvt_pk_bf16(s0[0], s0[1]); o[1] = cvt_pk_bf16(s0[2], s0[3]); o[2] = cvt_pk_bf16(s1[0], s1[1]); o[3] = cvt_pk_bf16(s1[2], s1[3]);
        *(u32x4*)((bf16_t*)(G(p.ws) + OFF_OX) + (size_t)row * DM + col) = o;
      }
    }
  }
  __syncthreads();
}

#define S5_NG 48
#define S5_USTR 1040
#define S5_HSTR 528

__device__ __forceinline__ float gelu_as(float v) {
  const float av = fabsf(v), t = __builtin_amdgcn_rcpf(av * 0.2316418882f + 1.0f);
  float q = t * 0.5307027145f + (-0.7265760135f); q = q * t + 0.7107068705f; q = q * t + (-0.142248368f); q = q * t + 0.127414796f; q = q * t;
  const float e = __builtin_amdgcn_exp2f((v * v) * (-0.72134752044f));
  const float m = v * (q * e);
  return v < 0.f ? m : v - m;
}
__device__ __forceinline__ unsigned pk_bf16(float lo, float hi) { return cvt_pk_bf16(lo, hi); }

__device__ void s5_phase(const Params& p, int j, int bid, int nblk, int tidx) {
  bf16_t* KcL = (bf16_t*)g_smem;
  float* pw = (float*)(g_smem + 32768);
  float* cc = pw + 2 * 33 * 64 * 2;
  unsigned char* UL = g_smem + 83200;
  unsigned char* HL = UL + 32 * S5_USTR;
  float* bbar = (float*)(g_smem + 133376);
#define S5P ((const bf16_t*)(G(p.ws) + OFF_P))
#define S5YG ((bf16_t*)(G(p.ws) + OFF_YG))
#pragma unroll 1
  for (int gi = bid; gi < 256; gi += nblk) {
    const int g = (gi & 7) * 32 + (gi >> 3);
    int tid = tidx; asm volatile("" : "+v"(tid));
    const int lane = tid & 63, wid = tid >> 6, fr = lane & 15, fq = lane >> 4;
#define S5S ((float*)(G(p.ws) + OFF_S5SCR + (size_t)g * S5_PER + S5_S))
#define S5HB ((bf16_t*)(G(p.ws) + OFF_S5SCR + (size_t)g * S5_PER + S5_H))
#define S5_TABLES() do { \
      for (int idx = tid; idx < 2 * 33 * 64; idx += NTHREADS) { \
        const int d_ = idx / (33 * 64), m_ = (idx >> 6) % 33, pp_ = idx & 63; \
        const size_t gi_ = ((size_t)(j * 2 + d_) * 256 + g); \
        const float lr_ = G(p.s5_lam_re)[gi_ * 64 + pp_], li_ = G(p.s5_lam_im)[gi_ * 64 + pp_]; \
        const float dt_ = expf(G(p.s5_log_dt)[gi_]); \
        const float mag_ = expf(lr_ * dt_ * (float)m_); \
        double rv_ = (double)li_ * (double)dt_ * 0.15915494309189535 * (double)m_; rv_ -= rint(rv_); \
        pw[idx * 2 + 0] = mag_ * __builtin_amdgcn_cosf((float)rv_); \
        pw[idx * 2 + 1] = mag_ * __builtin_amdgcn_sinf((float)rv_); } \
      for (int e_ = tid; e_ < 2 * 16 * 64; e_ += NTHREADS) { \
        const int d_ = e_ >> 10, c_ = (e_ >> 6) & 15, pp_ = e_ & 63; \
        const size_t ci_ = (((size_t)(j * 2 + d_) * 256 + g) * 16 + c_) * 64 + pp_; \
        cc[((d_ * 16 + c_) * 65 + pp_) * 2 + 0] = G(p.s5_c_re)[ci_]; cc[((d_ * 16 + c_) * 65 + pp_) * 2 + 1] = G(p.s5_c_im)[ci_]; } \
    } while (0)
    __syncthreads();
    S5_TABLES();
    __syncthreads();
    for (int e = tid; e < 2 * 64 * 16; e += NTHREADS) {
      const int d = e >> 10, pp = (e >> 4) & 63, c = e & 15;
      const size_t gi = ((size_t)(j * 2 + d) * 256 + g);
      const float lr = G(p.s5_lam_re)[gi * 64 + pp], li = G(p.s5_lam_im)[gi * 64 + pp];
      const float ar1 = pw[((d * 33 + 1) * 64 + pp) * 2], ai1 = pw[((d * 33 + 1) * 64 + pp) * 2 + 1];
      const float den = lr * lr + li * li;
      const float qr = ((ar1 - 1.0f) * lr + ai1 * li) / den;
      const float qi = (ai1 * lr - (ar1 - 1.0f) * li) / den;
      const float b_r = G(p.s5_b_re)[(gi * 64 + pp) * 16 + c], b_i = G(p.s5_b_im)[(gi * 64 + pp) * 16 + c];
      bbar[e * 2 + 0] = qr * b_r - qi * b_i;
      bbar[e * 2 + 1] = qr * b_i + qi * b_r;
    }
    __syncthreads();
    {
#pragma unroll 1
      for (int a = 0; a < 4; ++a) {
        const int tau = wid * 4 + a;
        f32x4 acc = (f32x4){0.f, 0.f, 0.f, 0.f};
#pragma unroll
        for (int d = 0; d < 2; ++d) {
#pragma unroll
          for (int ks = 0; ks < 4; ++ks) {
            const int p0 = ks * 16 + fq * 4;
            u32x4 afu, bfu;
#pragma unroll
            for (int i = 0; i < 4; ++i) {
              const float cr = cc[((d * 16 + fr) * 65 + p0 + i) * 2], ci = cc[((d * 16 + fr) * 65 + p0 + i) * 2 + 1];
              const float pr = pw[((d * 33 + tau) * 64 + p0 + i) * 2], pi = pw[((d * 33 + tau) * 64 + p0 + i) * 2 + 1];
              afu[i] = pk_bf16(cr * pr - ci * pi, -(cr * pi + ci * pr));
              bfu[i] = pk_bf16(bbar[((d * 64 + p0 + i) * 16 + fr) * 2], bbar[((d * 64 + p0 + i) * 16 + fr) * 2 + 1]);
            }
            acc = MFMA16(__builtin_bit_cast(bf16x8, afu), __builtin_bit_cast(bf16x8, bfu), acc);
          }
          if (tau != 0 || d == 1) {
            const int dl = (tau == 0) ? 0 : (d ? -tau : tau);
#pragma unroll
            for (int r = 0; r < 4; ++r) KcL[((dl + 31) * 16 + fq * 4 + r) * 16 + fr] = f2bf(acc[r]);
            acc = (f32x4){0.f, 0.f, 0.f, 0.f};
          }
        }
      }
    }
    float atr2[2][2];
    { const int dp = tid & 127; atr2[0][0] = atr2[1][0] = pw[(((dp >> 6) * 33 + 32) * 64 + (dp & 63)) * 2]; atr2[0][1] = atr2[1][1] = pw[(((dp >> 6) * 33 + 32) * 64 + (dp & 63)) * 2 + 1]; }
    {
      u32x4 w1f[2][16];
#pragma unroll
      for (int a = 0; a < 2; ++a) {
        const int R = (wid * 2 + a) * 16 + fr, dR = R >> 7, pp = (R & 127) >> 1, ri = R & 1;
        float br[8], bi[8];
#pragma unroll
        for (int i = 0; i < 8; ++i) { br[i] = bbar[((dR * 64 + pp) * 16 + (fq & 1) * 8 + i) * 2]; bi[i] = bbar[((dR * 64 + pp) * 16 + (fq & 1) * 8 + i) * 2 + 1]; }
#pragma unroll
        for (int ks = 0; ks < 16; ++ks) {
          const int s = ks * 2 + (fq >> 1), e = dR ? s : (31 - s);
          const float pr = pw[((dR * 33 + e) * 64 + pp) * 2], pi = pw[((dR * 33 + e) * 64 + pp) * 2 + 1];
#pragma unroll
          for (int i = 0; i < 4; ++i) {
            const float lo = ri ? (pr * bi[2 * i] + pi * br[2 * i]) : (pr * br[2 * i] - pi * bi[2 * i]);
            const float hi = ri ? (pr * bi[2 * i + 1] + pi * br[2 * i + 1]) : (pr * br[2 * i + 1] - pi * bi[2 * i + 1]);
            w1f[a][ks][i] = pk_bf16(lo, hi);
          }
          __builtin_amdgcn_sched_barrier(0);
        }
      }
      __syncthreads();
      us8 pu[4];
#define S5_ULOADX(ngx, R_) do { _Pragma("unroll") for (int i = 0; i < 4; ++i) { \
          const int piece = tid + NTHREADS * i, half = piece & 1, s = (piece >> 1) & 31, chl = piece >> 6; \
          const int ch = min((ngx) * 32 + chl, 263); \
          R_[i] = *(const us8*)(S5P + (size_t)(ch * 32 + s) * 8192 + g * 16 + half * 8); } } while (0)
#define S5_USTOREX(R_) do { _Pragma("unroll") for (int i = 0; i < 4; ++i) { \
          const int piece = tid + NTHREADS * i, half = piece & 1, s = (piece >> 1) & 31, chl = piece >> 6; \
          *(us8*)(UL + chl * S5_USTR + s * 32 + half * 16) = R_[i]; } } while (0)
#define S5_ULOAD(ngx) S5_ULOADX(ngx, pu)
#define S5_USTORE() S5_USTOREX(pu)
#define S5_STEP4(ng_, RC_) do { \
        S5_USTOREX(RC_); \
        __syncthreads(); \
        if ((ng_) + 1 < 9) S5_ULOADX((ng_) + 1, RC_); \
        f32x4 acc[2][2]; \
        _Pragma("unroll") for (int a = 0; a < 2; ++a) _Pragma("unroll") for (int q = 0; q < 2; ++q) acc[a][q] = (f32x4){0.f, 0.f, 0.f, 0.f}; \
        _Pragma("unroll") for (int ks = 0; ks < 16; ++ks) { \
          bf16x8 bf[2]; \
          _Pragma("unroll") for (int q = 0; q < 2; ++q) bf[q] = *(const bf16x8*)(UL + (q * 16 + fr) * S5_USTR + (ks * 2 + (fq >> 1)) * 32 + (fq & 1) * 16); \
          _Pragma("unroll") for (int a = 0; a < 2; ++a) _Pragma("unroll") for (int q = 0; q < 2; ++q) acc[a][q] = MFMA16(__builtin_bit_cast(bf16x8, w1f[a][ks]), bf[q], acc[a][q]); } \
        _Pragma("unroll") for (int a = 0; a < 2; ++a) _Pragma("unroll") for (int q = 0; q < 2; ++q) { \
            const int ch = (ng_) * 32 + q * 16 + fr; \
            if (ch < 264) *(f32x4*)(S5S + (size_t)ch * 256 + (wid * 2 + a) * 16 + fq * 4) = acc[a][q]; } \
        __syncthreads(); } while (0)
      S5_ULOADX(0, pu);
#pragma unroll 1
      for (int ng = 0; ng < 9; ++ng) { S5_STEP4(ng, pu); }
    }
    __syncthreads();
    {
      float* segend = (float*)UL;
      float* carry = segend + 8 * 128 * 2;
#pragma unroll 1
      for (int r = 0; r < 2; ++r) {
        const int item = tid + NTHREADS * r, dp = item & 127, d = dp >> 6, seg = item >> 7;
        const float* Sp = S5S + d * 128 + 2 * (dp & 63);
        float sr[33], si[33];
#pragma unroll
        for (int q = 0; q < 33; ++q) {
          const int pos = seg * 33 + q, k = d ? (pos < 8 ? 7 - pos : 271 - pos) : pos;
          sr[q] = Sp[(size_t)k * 256]; si[q] = Sp[(size_t)k * 256 + 1];
        }
        float hr = 0.f, hi = 0.f;
        const float ar = atr2[0][0], ai = atr2[0][1];
#pragma unroll
        for (int q = 0; q < 33; ++q) {
          const float nr = ar * hr - ai * hi + sr[q], ni = ar * hi + ai * hr + si[q];
          hr = nr; hi = ni;
        }
        segend[(seg * 128 + dp) * 2] = hr; segend[(seg * 128 + dp) * 2 + 1] = hi;
      }
      __syncthreads();
      if (tid < 128) {
        float pr = atr2[0][0], pi = atr2[0][1];
        float p2r = pr, p2i = pi;
#pragma unroll
        for (int q = 0; q < 5; ++q) { const float t = p2r * p2r - p2i * p2i; p2i = 2.f * p2r * p2i; p2r = t; }
        const float Ar = p2r * pr - p2i * pi, Ai = p2r * pi + p2i * pr;
        float cr = 0.f, ci = 0.f;
#pragma unroll
        for (int j = 0; j < 8; ++j) {
          carry[(j * 128 + tid) * 2] = cr; carry[(j * 128 + tid) * 2 + 1] = ci;
          const float er = segend[(j * 128 + tid) * 2], ei = segend[(j * 128 + tid) * 2 + 1];
          const float nr = Ar * cr - Ai * ci + er, ni = Ar * ci + Ai * cr + ei;
          cr = nr; ci = ni;
        }
      }
      __syncthreads();
#pragma unroll 1
      for (int r = 0; r < 2; ++r) {
        const int item = tid + NTHREADS * r, dp = item & 127, d = dp >> 6, seg = item >> 7;
        const float* Sp = S5S + d * 128 + 2 * (dp & 63);
        bf16_t* Hp = S5HB + d * 128 + 2 * (dp & 63);
        float sr[33], si[33];
#pragma unroll
        for (int q = 0; q < 33; ++q) {
          const int pos = seg * 33 + q, k = d ? (pos < 8 ? 7 - pos : 271 - pos) : pos;
          sr[q] = Sp[(size_t)k * 256]; si[q] = Sp[(size_t)k * 256 + 1];
        }
        float hr = carry[(seg * 128 + dp) * 2], hi = carry[(seg * 128 + dp) * 2 + 1];
        const float ar = atr2[0][0], ai = atr2[0][1];
#pragma unroll
        for (int q = 0; q < 33; ++q) {
          const int pos = seg * 33 + q, k = d ? (pos < 8 ? 7 - pos : 271 - pos) : pos;
          *(unsigned*)(Hp + (size_t)k * 256) = pk_bf16(hr, hi);
          const float nr = ar * hr - ai * hi + sr[q], ni = ar * hi + ai * hr + si[q];
          hr = nr; hi = ni;
        }
      }
    }
    __syncthreads();
#pragma unroll 1
    for (int half = 0; half < 2; ++half) {
      u32x4 w2f[2][8];
#pragma unroll
      for (int a = 0; a < 2; ++a) {
        const int t = wid * 4 + half * 2 + a;
#pragma unroll
        for (int kq = 0; kq < 8; ++kq) {
          const int d2 = kq >> 2, p0 = (kq & 3) * 16 + fq * 4, e = d2 ? (32 - t) : (t + 1);
#pragma unroll
          for (int i = 0; i < 4; ++i) {
            const float cr = cc[((d2 * 16 + fr) * 65 + p0 + i) * 2], ci = cc[((d2 * 16 + fr) * 65 + p0 + i) * 2 + 1];
            const float pr = pw[((d2 * 33 + e) * 64 + p0 + i) * 2], pi = pw[((d2 * 33 + e) * 64 + p0 + i) * 2 + 1];
            w2f[a][kq][i] = pk_bf16(cr * pr - ci * pi, -(cr * pi + ci * pr));
          }
          __builtin_amdgcn_sched_barrier(0);
        }
      }
      us8 pu[4], pv[4], phh[2], phv[2];
#define S5_HLOADX(ngx, R_) do { _Pragma("unroll") for (int i = 0; i < 2; ++i) { \
          const int piece = tid + NTHREADS * i, chl = piece >> 5, k8 = (piece & 31) * 8; \
          const int ch = min((ngx) * 32 + chl, 263); \
          R_[i] = *(const us8*)(S5HB + (size_t)ch * 256 + k8); } } while (0)
#define S5_HSTOREX(R_) do { _Pragma("unroll") for (int i = 0; i < 2; ++i) { \
          const int piece = tid + NTHREADS * i, chl = piece >> 5, k8 = (piece & 31) * 8; \
          *(us8*)(HL + chl * S5_HSTR + k8 * 2) = R_[i]; } } while (0)
#define S5_STEP6(ng_, RU_, RH_) do { \
        S5_USTOREX(RU_); S5_HSTOREX(RH_); \
        __syncthreads(); \
        if ((ng_) + 2 < 9) { S5_ULOADX((ng_) + 2, RU_); S5_HLOADX((ng_) + 2, RH_); } \
        f32x4 acc[2][2]; \
        _Pragma("unroll") for (int a = 0; a < 2; ++a) _Pragma("unroll") for (int q = 0; q < 2; ++q) acc[a][q] = (f32x4){0.f, 0.f, 0.f, 0.f}; \
        _Pragma("unroll 1") for (int ks = 0; ks < 16; ++ks) { \
          bf16x8 af[2], bf[2]; \
          const int s = ks * 2 + (fq >> 1); \
          _Pragma("unroll") for (int a = 0; a < 2; ++a) af[a] = *(const bf16x8*)(KcL + ((wid * 4 + half * 2 + a - s + 31) * 16 + fr) * 16 + (fq & 1) * 8); \
          _Pragma("unroll") for (int q = 0; q < 2; ++q) bf[q] = *(const bf16x8*)(UL + (q * 16 + fr) * S5_USTR + s * 32 + (fq & 1) * 16); \
          _Pragma("unroll") for (int a = 0; a < 2; ++a) _Pragma("unroll") for (int q = 0; q < 2; ++q) acc[a][q] = MFMA16(af[a], bf[q], acc[a][q]); } \
        _Pragma("unroll") for (int kq = 0; kq < 8; ++kq) { \
          bf16x8 bf[2]; \
          _Pragma("unroll") for (int q = 0; q < 2; ++q) bf[q] = *(const bf16x8*)(HL + (q * 16 + fr) * S5_HSTR + (kq * 32 + fq * 8) * 2); \
          _Pragma("unroll") for (int a = 0; a < 2; ++a) _Pragma("unroll") for (int q = 0; q < 2; ++q) acc[a][q] = MFMA16(__builtin_bit_cast(bf16x8, w2f[a][kq]), bf[q], acc[a][q]); } \
        const f32x4 dsk = *(const f32x4*)(G(p.s5_d) + (size_t)j * EI + g * 16 + fq * 4); \
        _Pragma("unroll") for (int a = 0; a < 2; ++a) _Pragma("unroll") for (int q = 0; q < 2; ++q) { \
            const int ch = (ng_) * 32 + q * 16 + fr; \
            if (ch < 264) { \
              const int t = wid * 4 + half * 2 + a; \
              const int row = ch * 32 + t; \
              const us4 uv = *(const us4*)(UL + (q * 16 + fr) * S5_USTR + t * 32 + fq * 8); \
              const float v0 = acc[a][q][0] + dsk[0] * bf2f(uv[0]); \
              const float v1 = acc[a][q][1] + dsk[1] * bf2f(uv[1]); \
              const float v2 = acc[a][q][2] + dsk[2] * bf2f(uv[2]); \
              const float v3 = acc[a][q][3] + dsk[3] * bf2f(uv[3]); \
              unsigned __attribute__((ext_vector_type(2))) o; \
              o[0] = cvt_pk_bf16(gelu_as(v0), gelu_as(v1)); o[1] = cvt_pk_bf16(gelu_as(v2), gelu_as(v3)); \
              *(unsigned __attribute__((ext_vector_type(2)))*)(S5YG + (size_t)row * EI + g * 16 + fq * 4) = o; } } \
        __syncthreads(); } while (0)
      S5_ULOADX(0, pu); S5_HLOADX(0, phh); S5_ULOADX(1, pv); S5_HLOADX(1, phv);
#pragma unroll 1
      for (int ng = 0; ng < 8; ng += 2) { S5_STEP6(ng, pu, phh); S5_STEP6(ng + 1, pv, phv); }
      S5_STEP6(8, pu, phh);
    }
#undef S5_TABLES
  }
}

__device__ __forceinline__ float fexp(float x) { return __expf(x); }
__device__ __forceinline__ float frcp(float x) { return __builtin_amdgcn_rcpf(x); }

__device__ void hgrn_pre_phase(const Params& p, int j, int bid, int nblk, int tidx) {
  const int tid = tidx, lane = tid & 63, wid = tid >> 6, fr = lane & 15, fq = lane >> 4;
  float* gbuf = (float*)g_smem;
  float* tot = gbuf + 64 * 128;
  float* cem = tot + 512;
  float* celm = cem + 128;
  bf16_t* qe = (bf16_t*)(celm + 128);
  bf16_t* ke = qe + 64 * 136;
  bf16_t* kbT = ke + 64 * 136;
  bf16_t* vT = kbT + 128 * 72;
  bf16_t* sc = vT + 128 * 72;
  bf16_t* P = (bf16_t*)(G(p.ws) + OFF_P);
  bf16_t* QB = (bf16_t*)(G(p.ws) + OFF_QB);
  bf16_t* VT = (bf16_t*)(G(p.ws) + OFF_VT);
  float* DEC = (float*)(G(p.ws) + OFF_DEC);
  const int tau = tid >> 3, dk0 = (tid & 7) * 16, swz = (tid & 7) * 8;
  us8 nf0, nf1, nq0, nq1, nv0, nv1;
  float lbv[16];
#pragma unroll
  for (int e = 0; e < 16; ++e) lbv[e] = 0.f;
  int cur_hd = -1;
  if (bid < 8448) {
    const int item = bid, d = item & 1, h = (item >> 1) & 31, chunk = item >> 6;
    const size_t row = (size_t)chunk * 64 + (d ? 63 - tau : tau);
    const bf16_t* rp = P + row * 20480 + h * 128 + dk0;
    nf0 = *(const us8*)(rp + (1 + d) * EI); nf1 = *(const us8*)(rp + (1 + d) * EI + 8);
    nq0 = *(const us8*)(rp + 3 * EI); nq1 = *(const us8*)(rp + 3 * EI + 8);
    nv0 = *(const us8*)(rp); nv1 = *(const us8*)(rp + 8);
  }
#pragma unroll 1
  for (int item = bid; item < 8448; item += nblk) {
    const int d = item & 1, h = (item >> 1) & 31, chunk = item >> 6;
    bf16_t* O = (bf16_t*)(G(p.ws) + OFF_OFB) + (size_t)d * MROWS * EI;
    float kk[16], qq[16];
    {
      const us8 cf0 = nf0, cf1 = nf1, cq0 = nq0, cq1 = nq1, cv0 = nv0, cv1 = nv1;
      if (j != 0 && (h * 2 + d) != cur_hd) {
        cur_hd = h * 2 + d;
#pragma unroll
        for (int e = 0; e < 16; ++e) {
          const float l0 = G(p.hgrn_lb)[(size_t)(d * 2 + 0) * EI + h * 128 + dk0 + e];
          const float l1 = G(p.hgrn_lb)[(size_t)(d * 2 + 1) * EI + h * 128 + dk0 + e];
          const float mx = fmaxf(l0, l1);
          const float e0 = expf(l0 - mx), e1 = expf(l1 - mx);
          const float p0 = e0 / (e0 + e1), p1 = e1 / (e0 + e1);
          lbv[e] = (p0 + p1) - p0;
        }
      }
#pragma unroll
      for (int e = 0; e < 16; ++e) {
        float f = bf2f(e < 8 ? cf0[e & 7] : cf1[e & 7]);
        f = fminf(fmaxf(f, -30.f), 30.f);
        const float ef = fexp(-f), sg = frcp(1.0f + ef);
        const float lb = lbv[e];
        const float gg = (j == 0) ? -__logf(1.0f + ef) : __logf(lb + (1.0f - lb) * sg);
        gbuf[tau * 128 + dk0 + e] = gg;
        kk[e] = (1.0f - lb) * ef * sg;
        float qv = bf2f(e < 8 ? cq0[e & 7] : cq1[e & 7]);
        const float qc = fminf(fmaxf(qv, -30.f), 30.f);
        qq[e] = qv * frcp(1.0f + fexp(-qc));
        vT[(dk0 + e) * 72 + (tau ^ swz)] = (e < 8 ? cv0[e & 7] : cv1[e & 7]);
      }
    }
    if (item + nblk < 8448) {
      const int it2 = item + nblk, d2 = it2 & 1, h2 = (it2 >> 1) & 31, c2 = it2 >> 6;
      const size_t row = (size_t)c2 * 64 + (d2 ? 63 - tau : tau);
      const bf16_t* rp = P + row * 20480 + h2 * 128 + dk0;
      nf0 = *(const us8*)(rp + (1 + d2) * EI); nf1 = *(const us8*)(rp + (1 + d2) * EI + 8);
      nq0 = *(const us8*)(rp + 3 * EI); nq1 = *(const us8*)(rp + 3 * EI + 8);
      nv0 = *(const us8*)(rp); nv1 = *(const us8*)(rp + 8);
    }
    __syncthreads();
    {
      const int dkc = tid & 127, part = tid >> 7;
      float loc[16], run = 0.f;
#pragma unroll
      for (int t = 0; t < 16; ++t) { run += gbuf[(part * 16 + t) * 128 + dkc]; loc[t] = run; }
      tot[part * 128 + dkc] = run;
      __syncthreads();
      float off = 0.f;
      for (int pp = 0; pp < part; ++pp) off += tot[pp * 128 + dkc];
#pragma unroll
      for (int t = 0; t < 16; ++t) gbuf[(part * 16 + t) * 128 + dkc] = loc[t] + off;
    }
    __syncthreads();
    if (tid < 128) {
      const float bm = gbuf[31 * 128 + tid], bl = gbuf[63 * 128 + tid];
      cem[tid] = fexp(bm); celm[tid] = fexp(bl - bm);
      DEC[((size_t)(chunk * 32 + h) * 2 + d) * 128 + tid] = fexp(bl);
    }
    __syncthreads();
    {
      us8 oq[2], ok[2], ob[2];
      const int rn = d ? 63 - tau : tau;
#pragma unroll
      for (int e = 0; e < 16; ++e) {
        const float bc = gbuf[tau * 128 + dk0 + e], bm = gbuf[31 * 128 + dk0 + e];
        const float E1 = fexp(fminf(fmaxf(bc - bm, -80.f), 80.f)), R1 = frcp(E1);
        const float qev = qq[e] * E1, kev = kk[e] * R1;
        oq[e >> 3][e & 7] = f2bf(qev);
        ok[e >> 3][e & 7] = f2bf(kev);
        ob[e >> 3][e & 7] = f2bf(qev * cem[dk0 + e]);
        kbT[(dk0 + e) * 72 + (rn ^ swz)] = f2bf(kev * celm[dk0 + e]);
      }
      *(us8*)(qe + tau * 136 + dk0) = oq[0]; *(us8*)(qe + tau * 136 + dk0 + 8) = oq[1];
      *(us8*)(ke + tau * 136 + dk0) = ok[0]; *(us8*)(ke + tau * 136 + dk0 + 8) = ok[1];
      {
        bf16_t* qbase = QB + (size_t)((d * 132 + chunk) * 32 + h) * 8192;
        const int k8 = dk0 >> 3;
        *(us8*)(qbase + ((tau >> 4) * 4 + (k8 >> 2)) * 512 + ((tau & 15) + 16 * (k8 & 3)) * 8) = ob[0];
        *(us8*)(qbase + ((tau >> 4) * 4 + ((k8 + 1) >> 2)) * 512 + ((tau & 15) + 16 * ((k8 + 1) & 3)) * 8) = ob[1];
      }
    }
    __syncthreads();
    {
      const int mt = wid >> 1;
#pragma unroll
      for (int nn = 0; nn < 2; ++nn) {
        const int nt2 = (wid & 1) * 2 + nn;
        f32x4 a4 = (f32x4){0.f, 0.f, 0.f, 0.f};
#pragma unroll
        for (int ks = 0; ks < 4; ++ks) {
          const bf16x8 a = *(const bf16x8*)(qe + (mt * 16 + fr) * 136 + ks * 32 + fq * 8);
          const bf16x8 b = *(const bf16x8*)(ke + (nt2 * 16 + fr) * 136 + ks * 32 + fq * 8);
          a4 = MFMA16(a, b, a4);
        }
        const int s = nt2 * 16 + fr;
#pragma unroll
        for (int r = 0; r < 4; ++r) {
          const int t = mt * 16 + fq * 4 + r;
          sc[t * 72 + s] = (s <= t) ? f2bf(a4[r]) : (bf16_t)0;
        }
      }
    }
    __syncthreads();
    {
      bf16x8 av[2];
#pragma unroll
      for (int ks = 0; ks < 2; ++ks) av[ks] = *(const bf16x8*)(vT + (wid * 16 + fr) * 72 + ((ks * 32 + fq * 8) ^ ((wid & 7) * 8)));
#pragma unroll
      for (int jt = 0; jt < 4; ++jt) {
        f32x4 a4 = (f32x4){0.f, 0.f, 0.f, 0.f};
#pragma unroll
        for (int ks = 0; ks < 2; ++ks) {
          const bf16x8 b = *(const bf16x8*)(sc + (jt * 16 + fr) * 72 + ks * 32 + fq * 8);
          a4 = MFMA16(av[ks], b, a4);
        }
        unsigned __attribute__((ext_vector_type(2))) o;
        o[0] = cvt_pk_bf16(a4[0], a4[1]); o[1] = cvt_pk_bf16(a4[2], a4[3]);
        *(unsigned __attribute__((ext_vector_type(2)))*)((bf16_t*)(G(p.ws) + OFF_OFB) + (size_t)((d * 132 + chunk) * 32 + h) * 8192 + ((wid * 4 + jt) * 64 + lane) * 4) = o;
      }
#pragma unroll
      for (int i2 = 0; i2 < 2; ++i2) {
        const int piece = tid + 512 * i2, blk_ = piece >> 6, ln_ = piece & 63;
        const int dk = (blk_ >> 1) * 16 + (ln_ & 15), r8i = (blk_ & 1) * 4 + (ln_ >> 4), r8 = r8i * 8;
        const us8 kv = *(const us8*)(kbT + dk * 72 + (r8 ^ (((dk >> 4) & 7) * 8)));
        const int fo = piece * 16;
        *(us8*)(P + ((size_t)chunk * 64 + (fo >> 8)) * 20480 + (1 + d) * EI + h * 128 + ((fo & 255) >> 1)) = kv;
        if (d == 0) {
          const us8 vv = *(const us8*)(vT + dk * 72 + (r8 ^ (((dk >> 4) & 7) * 8)));
          *(us8*)(VT + (size_t)(chunk * 32 + h) * 8192 + (fo >> 1)) = vv;
        }
      }
    }
    __syncthreads();
  }
}

__device__ void hgrn_seq_phase(const Params& p, int j, int bid, int nblk, int tidx) {
  const int tid = tidx, lane = tid & 63, wid = tid >> 6, fr = lane & 15, fq = lane >> 4;
  bf16_t* ST = (bf16_t*)g_smem;
  const bf16_t* P = (const bf16_t*)(G(p.ws) + OFF_P);
  const bf16_t* QB = (const bf16_t*)(G(p.ws) + OFF_QB);
  const bf16_t* VT = (const bf16_t*)(G(p.ws) + OFF_VT);
  const float* DEC = (const float*)(G(p.ws) + OFF_DEC);
  const int it = wid & 1, jt = wid >> 1;
#pragma unroll 1
  for (int item = bid; item < 256; item += nblk) {
    const int vs = (item >> 3) & 3, hd = (item & 7) + 8 * (item >> 5), h = hd >> 1, d = hd & 1;
    bf16_t* O = (bf16_t*)(G(p.ws) + OFF_OFB) + (size_t)d * MROWS * EI;
    __syncthreads();
    for (int i = tid; i < 2 * 32 * 136; i += NTHREADS) ST[i] = 0;
    f32x4 accS[2];
    accS[0] = (f32x4){0.f, 0.f, 0.f, 0.f}; accS[1] = (f32x4){0.f, 0.f, 0.f, 0.f};
    bf16x8 Aqb[4], Akb[2], Avt[2][2]; f32x4 Adc; us4 Aoi;
    bf16x8 Bqb[4], Bkb[2], Bvt[2][2]; f32x4 Bdc; us4 Boi;
    bf16x8 Cqb[4], Ckb[2], Cvt[2][2]; f32x4 Cdc; us4 Coi;
    const int dkr = 16 * wid + fr;
    const int tq = jt * 16 + fr;
#define CHAIN(n_) (d ? ((n_) < 4 ? 3 - (n_) : 135 - (n_)) : (n_))
#define HSEQ_LOAD(c, S_) do { \
      const bf16_t* qp_ = QB + (size_t)((d * 132 + (c)) * 32 + h) * 8192 + jt * 4 * 512 + lane * 8; \
      _Pragma("unroll") for (int ks = 0; ks < 4; ++ks) S_##qb[ks] = *(const bf16x8*)(qp_ + ks * 512); \
      _Pragma("unroll") for (int ks = 0; ks < 2; ++ks) S_##kb[ks] = *(const bf16x8*)(P + ((size_t)(c) * 64 + (wid * 2 + ks) * 4 + fq) * 20480 + (1 + d) * EI + h * 128 + fr * 8); \
      _Pragma("unroll") for (int nn = 0; nn < 2; ++nn) { \
        const bf16_t* vp_ = VT + (size_t)((c) * 32 + h) * 8192 + ((vs * 2 + nn) * 2) * 512 + lane * 8; \
        _Pragma("unroll") for (int ks = 0; ks < 2; ++ks) S_##vt[nn][ks] = *(const bf16x8*)(vp_ + ks * 512); } \
      S_##dc = *(const f32x4*)(DEC + ((size_t)((c) * 32 + h) * 2 + d) * 128 + 16 * wid + fq * 4); \
    } while (0)
#define HSEQ_STEP(n_, C_, L_) do { \
      const int n = (n_); const int chunk = CHAIN(n); const int cur = n & 1; \
      if (n + 2 < 132) { const int nc = CHAIN(n + 2); HSEQ_LOAD(nc, L_); } \
      { f32x4 a4 = (f32x4){0.f, 0.f, 0.f, 0.f}; \
        const bf16_t* stc = ST + cur * 32 * 136; \
        _Pragma("unroll") for (int ks = 0; ks < 4; ++ks) { \
          const bf16x8 a = *(const bf16x8*)(stc + (it * 16 + fr) * 136 + ks * 32 + fq * 8); \
          a4 = MFMA16(a, C_##qb[ks], a4); } \
        us4 o; \
        _Pragma("unroll") for (int r = 0; r < 4; ++r) o[r] = f2bf(a4[r] + bf2f(oic[(n_) - n0][r])); \
        obuf[(n_) - n0] = o; } \
      { bf16_t* stn = ST + (cur ^ 1) * 32 * 136; \
        _Pragma("unroll") for (int nn = 0; nn < 2; ++nn) { \
          _Pragma("unroll") for (int r = 0; r < 4; ++r) accS[nn][r] *= C_##dc[r]; \
          _Pragma("unroll") for (int ks = 0; ks < 2; ++ks) accS[nn] = MFMA16(C_##kb[ks], C_##vt[nn][ks], accS[nn]); \
          us4 o; \
          _Pragma("unroll") for (int r = 0; r < 4; ++r) o[r] = f2bf(accS[nn][r]); \
          *(us4*)(stn + (nn * 16 + fr) * 136 + wid * 16 + fq * 4) = o; } } \
      asm volatile("s_waitcnt lgkmcnt(0)" ::: "memory"); __builtin_amdgcn_s_barrier(); asm volatile("" ::: "memory"); \
    } while (0)
    us4 oin[6];
#pragma unroll
    for (int k = 0; k < 6; ++k) {
      const int ck = CHAIN(k);
      oin[k] = *(const us4*)((const bf16_t*)(G(p.ws) + OFF_OFB) + (size_t)((d * 132 + ck) * 32 + h) * 8192 + (((vs * 2 + it) * 4 + jt) * 64 + lane) * 4);
    }
    { const int c0 = CHAIN(0); HSEQ_LOAD(c0, A); const int c1 = CHAIN(1); HSEQ_LOAD(c1, B); }
    __syncthreads();
#pragma unroll 1
    for (int n0 = 0; n0 < 132; n0 += 6) {
      us4 obuf[6], oic[6];
#pragma unroll
      for (int k = 0; k < 6; ++k) oic[k] = oin[k];
      if (n0 + 6 < 132) {
#pragma unroll
        for (int k = 0; k < 6; ++k) {
          const int ck = CHAIN(n0 + 6 + k);
          oin[k] = *(const us4*)((const bf16_t*)(G(p.ws) + OFF_OFB) + (size_t)((d * 132 + ck) * 32 + h) * 8192 + (((vs * 2 + it) * 4 + jt) * 64 + lane) * 4);
        }
      }
      HSEQ_STEP(n0, A, C);
      HSEQ_STEP(n0 + 1, B, A);
      HSEQ_STEP(n0 + 2, C, B);
      HSEQ_STEP(n0 + 3, A, C);
      HSEQ_STEP(n0 + 4, B, A);
      HSEQ_STEP(n0 + 5, C, B);
#pragma unroll
      for (int k = 0; k < 6; ++k) {
        const int ck = CHAIN(n0 + k);
        *(us4*)((bf16_t*)(G(p.ws) + OFF_OFB) + (size_t)((d * 132 + ck) * 32 + h) * 8192 + (((vs * 2 + it) * 4 + jt) * 64 + lane) * 4) = obuf[k];
      }
    }
#undef HSEQ_STEP
#undef CHAIN
#undef HSEQ_LOAD
  }
}

__device__ void hgrn_finish_phase(const Params& p, int j, int bid, int nblk, int tidx) {
  const int tid = tidx, lane = tid & 63, wid = tid >> 6, fr = lane & 15, fq = lane >> 4;
  const bf16_t* OF = (const bf16_t*)(G(p.ws) + OFF_OFB);
  const bf16_t* P = (const bf16_t*)(G(p.ws) + OFF_P);
  bf16_t* OH = (bf16_t*)(G(p.ws) + OFF_OH);
  const float* onorm = G(p.hgrn_norm) + (size_t)j * EI;
  float* tb = (float*)g_smem + wid * 2048;
#pragma unroll 1
  for (int wi = bid * 8 + wid; wi < 132 * 32 * 4; wi += nblk * 8) {
    const int jt = wi & 3, h = (wi >> 2) & 31, chunk = wi >> 7;
    const bf16_t* fb = OF + (size_t)((0 * 132 + chunk) * 32 + h) * 8192 + (jt * 64 + lane) * 4;
    const bf16_t* bb = OF + (size_t)((1 * 132 + chunk) * 32 + h) * 8192 + ((3 - jt) * 64 + (15 - fr) + 16 * fq) * 4;
    float o[8][4], ss = 0.f;
#pragma unroll
    for (int pp = 0; pp < 8; ++pp) {
      const us4 a = *(const us4*)(fb + pp * 1024), b = *(const us4*)(bb + pp * 1024);
#pragma unroll
      for (int e = 0; e < 4; ++e) { o[pp][e] = bf2f(a[e]) + bf2f(b[e]); ss += o[pp][e] * o[pp][e]; }
    }
    ss += __shfl_xor(ss, 16); ss += __shfl_xor(ss, 32);
    const float inv = rsqrtf(ss * (1.0f / 128.0f) + 1e-6f);
#pragma unroll
    for (int pp = 0; pp < 8; ++pp) {
      f32x4 t;
#pragma unroll
      for (int e = 0; e < 4; ++e) t[e] = o[pp][e] * inv;
      *(f32x4*)(tb + fr * 128 + (((pp * 4 + fq) ^ (fr & 7)) << 2)) = t;
    }
    const int c8 = (lane & 15) * 8, ch = h * 128 + c8;
    const f32x4 n0 = *(const f32x4*)(onorm + ch), n1 = *(const f32x4*)(onorm + ch + 4);
#pragma unroll
    for (int ps = 0; ps < 4; ++ps) {
      const int rr = ps * 4 + (lane >> 4);
      const f32x4 t0 = *(const f32x4*)(tb + rr * 128 + ((((lane & 15) * 2) ^ (rr & 7)) << 2));
      const f32x4 t1 = *(const f32x4*)(tb + rr * 128 + ((((lane & 15) * 2 + 1) ^ (rr & 7)) << 2));
      const size_t row = (size_t)chunk * 64 + jt * 16 + rr;
      const us8 z = *(const us8*)(P + row * 20480 + 4 * EI + ch);
      u32x4 out;
#pragma unroll
      for (int e = 0; e < 4; ++e) {
        const float v0 = (e < 2 ? t0[2 * e] * n0[2 * e] : t1[2 * e - 4] * n1[2 * e - 4]);
        const float v1 = (e < 2 ? t0[2 * e + 1] * n0[2 * e + 1] : t1[2 * e - 3] * n1[2 * e - 3]);
        const float z0 = bf2f(z[2 * e]), z1 = bf2f(z[2 * e + 1]);
        out[e] = cvt_pk_bf16(v0 * (z0 * sigmoidf_(z0)), v1 * (z1 * sigmoidf_(z1)));
      }
      *(u32x4*)(OH + row * EI + ch) = out;
    }
  }
}

#define NPHASES 24
__device__ __forceinline__ void decode_phase(int ph, int& layer, int& kind) {
  if (ph == 0) { layer = 0; kind = 0; return; }
  if (ph == 23) { layer = 4; kind = 1; return; }
  int q = ph - 1;
  if (q >= 11) { q -= 11; layer = 2; } else layer = 0;
  if (q < 5) { kind = (q == 0) ? 1 : (q == 1) ? 2 : (q == 2) ? 3 : (q == 3) ? 4 : 5; }
  else { q -= 5; layer += 1; kind = (q == 0) ? 1 : (q == 1) ? 2 : (q == 2) ? 6 : (q == 3) ? 7 : (q == 4) ? 8 : 5; }
}
__device__ void run_phase(const Params& p, int ph, int bid, int nblk, int tidx) {
  int i, kind; decode_phase(ph, i, kind);
#ifdef ONLYK
  if (!((ONLYK >> kind) & 1)) return;
#endif
  const int j = (i >> 1) & 1;
  const bool is_s5 = (i & 1) == 0;
  if (kind == 0) { adaln_phase(p, bid, nblk, tidx); __syncthreads(); convert_phase(p, bid, nblk, tidx); return; }
  if (kind == 1) { norm_phase(p, i, bid, nblk, tidx); return; }
  if (kind == 3) { s5_phase(p, j, bid, nblk, tidx); return; }
  if (kind == 6) { hgrn_pre_phase(p, j, bid, nblk, tidx); return; }
  if (kind == 7) { hgrn_seq_phase(p, j, bid, nblk, tidx); return; }
  if (kind == 8) { hgrn_finish_phase(p, j, bid, nblk, tidx); return; }
  const int s = (kind == 2) ? 1 : (kind == 4) ? 3 : 4;
  const bf16_t* A; const bf16_t* Bt; int N, K;
  if (s == 1) {
    A = (const bf16_t*)(G(p.ws) + OFF_HX); K = 2048;
    if (is_s5) { Bt = (const bf16_t*)(G(p.ws) + OFF_WS5IN + j * SZ_WS5IN); N = 8192; }
    else { Bt = (const bf16_t*)(G(p.ws) + OFF_WHIN + j * SZ_WHIN); N = 20480; }
  } else if (s == 3) {
    A = (const bf16_t*)(G(p.ws) + OFF_YG); Bt = (const bf16_t*)(G(p.ws) + OFF_WGLU + j * SZ_WGLU); N = 4096; K = 4096;
  } else {
    A = is_s5 ? (const bf16_t*)(G(p.ws) + OFF_V) : (const bf16_t*)(G(p.ws) + OFF_OH);
    Bt = is_s5 ? (const bf16_t*)(G(p.ws) + OFF_WS5OUT + j * SZ_WOUT) : (const bf16_t*)(G(p.ws) + OFF_WHOUT + j * SZ_WOUT);
    N = 2048; K = 4096;
  }
#ifndef RPTB
#define RPTB 1
#endif
#ifndef RPTS
#define RPTS 1
#endif
  const bool ctx_big = (s == 1) && !is_s5;
  gemm_phase(ctx_big ? A : A + (size_t)CTXL * K, Bt, ctx_big ? MROWS : SEQL, N, K, p, s, is_s5 ? 1 : 0, j, bid, nblk, tidx);
  if (!ctx_big && !(s == 4 && i == 3)) gemm_small_phase(A, Bt, N, K, p, s, is_s5 ? 1 : 0, j, bid, nblk, tidx);
}

#define XB_TMO      128
#define XB_XCNT(j)  (256  + 64 * (j))
#define XB_XSUB(j)  (1280 + 64 * (j))
#define XB_XGEN(j)  (2304 + 64 * (j))
#define XB_TOP      3328
#define XB_TOPGEN   3392
#define XCD_BAR_WORDS 3456
#define XB_SPIN_CAP (1u << 18)
__device__ __forceinline__ unsigned xb_ld(unsigned* p) { return __hip_atomic_load(p, __ATOMIC_RELAXED, __HIP_MEMORY_SCOPE_AGENT); }
__device__ __forceinline__ unsigned xb_add(unsigned* p, unsigned v) { return __hip_atomic_fetch_add(p, v, __ATOMIC_RELAXED, __HIP_MEMORY_SCOPE_AGENT); }
__device__ __forceinline__ unsigned xb_xcc_id() { return (unsigned)__builtin_amdgcn_s_getreg((3 << 11) | 20) & 0xFu; }
#define XB_SPIN(cond, bar) do { unsigned _sp = 0; while (cond) { __builtin_amdgcn_s_sleep(1); \
    if ((++_sp & 255u) == 0u) { if (xb_ld(&(bar)[XB_TMO])) break; if (_sp > XB_SPIN_CAP) { atomicAdd(&(bar)[XB_TMO], 1u); break; } } } } while (0)
__device__ __forceinline__ void xcd_barrier_complete(unsigned* bar, unsigned x, unsigned G, unsigned& nloc, unsigned& nx) {
  unsigned sum, cnt, mine, sp = 0u;
  for (;;) {
    sum = 0u; cnt = 0u; mine = 0u;
#pragma unroll
    for (unsigned j = 0; j < 16; ++j) { const unsigned c = xb_ld(&bar[XB_XCNT(j)]); sum += c; cnt += (c > 0u) ? 1u : 0u; mine = (j == x) ? c : mine; }
    if (sum == G) break;
    __builtin_amdgcn_s_sleep(1);
    if ((++sp & 255u) == 0u) { if (xb_ld(&bar[XB_TMO])) break; if (sp > XB_SPIN_CAP) { atomicAdd(&bar[XB_TMO], 1u); break; } }
  }
  nloc = mine > 0u ? mine : 1u; nx = cnt > 0u ? cnt : 1u;
}
__device__ __forceinline__ void xcd_barrier(unsigned* bar, volatile LAS unsigned* st, bool leader_thread, unsigned G) {
  asm volatile("s_waitcnt vmcnt(0)" ::: "memory");
  __syncthreads();
  if (leader_thread) {
    const unsigned x = xb_xcc_id();
    __builtin_amdgcn_s_waitcnt(0);
    unsigned nloc = st[0], nx = st[1];
    if (nloc == 0u) { xcd_barrier_complete(bar, x, G, nloc, nx); st[0] = nloc; st[1] = nx; }
    const unsigned old = xb_add(&bar[XB_XSUB(x)], 1u);
    const unsigned gen = old / nloc;
    if (old + 1u == (gen + 1u) * nloc) {
      __builtin_amdgcn_fence(__ATOMIC_RELEASE, "agent");
      asm volatile("s_waitcnt vmcnt(0)" ::: "memory");
      const unsigned og = xb_add(&bar[XB_TOP], 1u);
      const unsigned tg = og / nx;
      if (og + 1u == (tg + 1u) * nx) xb_add(&bar[XB_TOPGEN], 1u);
      else XB_SPIN(xb_ld(&bar[XB_TOPGEN]) == tg, bar);
      __builtin_amdgcn_fence(__ATOMIC_ACQUIRE, "agent");
      xb_add(&bar[XB_XGEN(x)], 1u);
      asm volatile("s_waitcnt vmcnt(0)" ::: "memory");
    } else {
      XB_SPIN(xb_ld(&bar[XB_XGEN(x)]) == gen, bar);
      __builtin_amdgcn_fence(__ATOMIC_ACQUIRE, "agent");
      asm volatile("s_waitcnt vmcnt(0)" ::: "memory");
    }
  }
  __syncthreads();
}

__global__ void __launch_bounds__(NTHREADS) mega(Params p, int ph_lo, int ph_hi) {
  cg::grid_group grid = cg::this_grid();
  const int wave_id = __builtin_amdgcn_readfirstlane((int)(threadIdx.x >> 6));
  {
    volatile LAS unsigned* st0 = (volatile LAS unsigned*)((LAS unsigned char*)g_smem + 149760);
    if (threadIdx.x < 2) st0[threadIdx.x] = 0u;
    __syncthreads();
    if (threadIdx.x == 0) (void)xb_add((unsigned*)(G(p.ws) + OFF_BAR) + XB_XCNT(xb_xcc_id()), 1u);
  }
#pragma unroll 1
  for (int ph = ph_lo; ph < ph_hi; ++ph) {
    const Params* pp = (const Params*)__builtin_amdgcn_kernarg_segment_ptr();
    asm volatile("" : "+s"(pp));
    int wv = wave_id; asm volatile("" : "+s"(wv));
    int tidx = wv * 64 + (int)__builtin_amdgcn_mbcnt_hi(~0u, __builtin_amdgcn_mbcnt_lo(~0u, 0u));
    asm volatile("" : "+v"(tidx));
    run_phase(*pp, ph, blockIdx.x, gridDim.x, tidx);
    if (ph + 1 < ph_hi) {
      if (ph == ph_lo) grid.sync();
      else xcd_barrier((unsigned*)(G(pp->ws) + OFF_BAR), (volatile LAS unsigned*)((LAS unsigned char*)g_smem + 149760), tidx == 0, gridDim.x);
    }
  }
}

extern "C" void kernel_launch(void* const* d_in, const int* in_sizes, int n_in, void* d_out, int out_size, void* d_ws, size_t ws_size,
                              hipStream_t stream) {
  static int grid_blocks = 0;
  if (!grid_blocks) {
    hipFuncSetAttribute((const void*)mega, hipFuncAttributeMaxDynamicSharedMemorySize, LDS_BYTES);
    int dev = 0, cus = 0, per_cu = 0;
    hipGetDevice(&dev);
    hipDeviceGetAttribute(&cus, hipDeviceAttributeMultiprocessorCount, dev);
    hipOccupancyMaxActiveBlocksPerMultiprocessor(&per_cu, mega, NTHREADS, LDS_BYTES);
    if (per_cu < 1) per_cu = 1;
    grid_blocks = cus * per_cu;
    if (grid_blocks > 256) grid_blocks = 256;
  }
  Params p{};
  const float* const* in = (const float* const*)d_in;
  p.x = (const float GAS*)in[0]; p.c = (const float GAS*)in[1]; p.ctx = (const float GAS*)in[2]; p.cctx = (const float GAS*)in[3]; p.ada_w = (const float GAS*)in[4]; p.ada_b = (const float GAS*)in[5]; p.norm_pre = (const float GAS*)in[6]; p.norm_post = (const float GAS*)in[7];
  p.s5_w_in = (const float GAS*)in[8]; p.s5_lam_re = (const float GAS*)in[9]; p.s5_lam_im = (const float GAS*)in[10]; p.s5_log_dt = (const float GAS*)in[11]; p.s5_b_re = (const float GAS*)in[12]; p.s5_b_im = (const float GAS*)in[13];
  p.s5_c_re = (const float GAS*)in[14]; p.s5_c_im = (const float GAS*)in[15]; p.s5_d = (const float GAS*)in[16]; p.s5_w_glu = (const float GAS*)in[17]; p.s5_b_glu = (const float GAS*)in[18]; p.s5_w_out = (const float GAS*)in[19];
  p.hgrn_w_in = (const float GAS*)in[20]; p.hgrn_lb = (const float GAS*)in[21]; p.hgrn_norm = (const float GAS*)in[22]; p.hgrn_w_out = (const float GAS*)in[23];
  p.out = (float GAS*)d_out; p.ws = (unsigned char GAS*)d_ws;
#if COOP
  hipMemsetAsync((char*)d_ws + OFF_BAR, 0, XCD_BAR_WORDS * 4, stream);
  int lo = 0, hi = NPHASES;
  void* args[] = {&p, &lo, &hi};
  hipError_t e = hipLaunchCooperativeKernel((void*)mega, dim3(grid_blocks), dim3(NTHREADS), args, LDS_BYTES, stream);
  if (e != hipSuccess) fprintf(stderr, "cooperative launch failed: %s (grid %d)\n", hipGetErrorString(e), grid_blocks);
#else
  for (int ph = 0; ph < NPHASES; ++ph) {
    hipLaunchKernelGGL(mega, dim3(grid_blocks), dim3(NTHREADS), LDS_BYTES, stream, p, ph, ph + 1);
  }
#endif
}
```

```cpp
#include <hip/hip_runtime.h>
#include <hip/hip_cooperative_groups.h>
#include <cstdio>
namespace cg = cooperative_groups;

#ifndef COOP
#define COOP 1
#endif

typedef unsigned short bf16_t;
typedef short bf16x8 __attribute__((ext_vector_type(8)));
typedef float f32x4 __attribute__((ext_vector_type(4)));
typedef unsigned short us4 __attribute__((ext_vector_type(4)));
typedef unsigned short us8 __attribute__((ext_vector_type(8)));
typedef unsigned u32x4 __attribute__((ext_vector_type(4)));

#define DM 2048
#define SEQL 8192
#define CTXL 256
#define MROWS 8448
#define EI 4096
#define NTHREADS 512
#define LDS_BYTES 149776

extern __shared__ __attribute__((aligned(16))) unsigned char g_smem[];

typedef __bf16 bf16v2_t __attribute__((ext_vector_type(2)));
typedef float f32x2_t __attribute__((ext_vector_type(2)));
__device__ __forceinline__ unsigned cvt_pk_bf16(float lo, float hi) { const f32x2_t v = {lo, hi}; return __builtin_bit_cast(unsigned, __builtin_convertvector(v, bf16v2_t)); }
__device__ __forceinline__ bf16_t f2bf(float f) { return (bf16_t)(cvt_pk_bf16(f, f) & 0xffffu); }
__device__ __forceinline__ float bf2f(bf16_t h) { return __uint_as_float(((unsigned)h) << 16); }
__device__ __forceinline__ float sigmoidf_(float x) { return 1.0f / (1.0f + __expf(-x)); }

constexpr size_t SZ_WS5IN = (size_t)8192 * 2048 * 2;
constexpr size_t SZ_WGLU = (size_t)4096 * 4096 * 2;
constexpr size_t SZ_WOUT = (size_t)2048 * 4096 * 2;
constexpr size_t SZ_WHIN = (size_t)20480 * 2048 * 2;
constexpr size_t OFF_WS5IN = 0;
constexpr size_t OFF_WGLU = OFF_WS5IN + 2 * SZ_WS5IN;
constexpr size_t OFF_WS5OUT = OFF_WGLU + 2 * SZ_WGLU;
constexpr size_t OFF_WHIN = OFF_WS5OUT + 2 * SZ_WOUT;
constexpr size_t OFF_WHOUT = OFF_WHIN + 2 * SZ_WHIN;
constexpr size_t OFF_MOD = OFF_WHOUT + 2 * SZ_WOUT;
constexpr size_t OFF_XCUR = OFF_MOD + 4 * 2 * 6144 * 4;
constexpr size_t OFF_HX = OFF_XCUR + (size_t)MROWS * DM * 4;
constexpr size_t OFF_OX = OFF_HX + (size_t)MROWS * DM * 2;
constexpr size_t OFF_P = OFF_OX + (size_t)MROWS * DM * 4;
constexpr size_t OFF_R = OFF_P + (size_t)MROWS * 20480 * 2;
constexpr size_t OFF_YG = OFF_R;
constexpr size_t OFF_V = OFF_YG + (size_t)MROWS * EI * 2;
constexpr size_t OFF_S5SCR = OFF_V + (size_t)MROWS * EI * 2;
constexpr size_t S5_S = 0;
constexpr size_t S5_H = S5_S + 270336;
constexpr size_t S5_PER = S5_H + 135168;
constexpr size_t OFF_OFB = OFF_R;
constexpr size_t OFF_QB = OFF_OFB + (size_t)2 * MROWS * EI * 2;
constexpr size_t OFF_VT = OFF_QB + (size_t)2 * MROWS * EI * 2;
constexpr size_t OFF_DEC = OFF_VT + (size_t)MROWS * EI * 2;
constexpr size_t OFF_OH = OFF_DEC + (size_t)132 * 32 * 2 * 128 * 4;
constexpr size_t OFF_BAR = OFF_OH + (size_t)MROWS * EI * 2;
constexpr size_t WS_TOTAL = OFF_BAR + 16384;
static_assert(WS_TOTAL <= (size_t)4 * 2 * 2048 * 20480 * 4, "workspace overflow");

#define GAS __attribute__((address_space(1)))
struct Params {
  const float GAS *x, *c, *ctx, *cctx, *ada_w, *ada_b, *norm_pre, *norm_post;
  const float GAS *s5_w_in, *s5_lam_re, *s5_lam_im, *s5_log_dt, *s5_b_re, *s5_b_im, *s5_c_re, *s5_c_im, *s5_d, *s5_w_glu, *s5_b_glu, *s5_w_out;
  const float GAS *hgrn_w_in, *hgrn_lb, *hgrn_norm, *hgrn_w_out;
  float GAS* out;
  unsigned char GAS* ws;
};

template <class T> __device__ __forceinline__ T* G(GAS T* q) { return (T*)q; }

__device__ void convert_phase(const Params& p, int bid, int nblk, int tidx) {
  float* tile = (float*)g_smem;
  const int tid = tidx;
  const int total = 45056;
  for (int T = bid; T < total; T += nblk) {
    int j = T / 22528, r = T % 22528;
    const float* src; bf16_t* dst; int K, N;
    if (r < 4096) { src = G(p.s5_w_in) + (size_t)j * 2048 * 8192; dst = (bf16_t*)(G(p.ws) + OFF_WS5IN + j * SZ_WS5IN); K = 2048; N = 8192; }
    else if (r < 8192) { r -= 4096; src = G(p.s5_w_glu) + (size_t)j * 4096 * 4096; dst = (bf16_t*)(G(p.ws) + OFF_WGLU + j * SZ_WGLU); K = 4096; N = 4096; }
    else if (r < 10240) { r -= 8192; src = G(p.s5_w_out) + (size_t)j * 4096 * 2048; dst = (bf16_t*)(G(p.ws) + OFF_WS5OUT + j * SZ_WOUT); K = 4096; N = 2048; }
    else if (r < 20480) { r -= 10240; src = G(p.hgrn_w_in) + (size_t)j * 2048 * 20480; dst = (bf16_t*)(G(p.ws) + OFF_WHIN + j * SZ_WHIN); K = 2048; N = 20480; }
    else { r -= 20480; src = G(p.hgrn_w_out) + (size_t)j * 4096 * 2048; dst = (bf16_t*)(G(p.ws) + OFF_WHOUT + j * SZ_WOUT); K = 4096; N = 2048; }
    const int nNt = N >> 6;
    const int k0 = (r / nNt) << 6, n0 = (r % nNt) << 6;
    {
      const int kk = tid >> 4, n4 = tid & 15;
#pragma unroll
      for (int ps = 0; ps < 2; ++ps) {
        const int k = ps * 32 + kk;
        f32x4 v = __builtin_nontemporal_load((const f32x4*)(src + (size_t)(k0 + k) * N + n0 + n4 * 4));
        tile[k * 65 + n4 * 4 + 0] = v[0]; tile[k * 65 + n4 * 4 + 1] = v[1];
        tile[k * 65 + n4 * 4 + 2] = v[2]; tile[k * 65 + n4 * 4 + 3] = v[3];
      }
    }
    __syncthreads();
    {
      const int n = tid >> 3, k8 = tid & 7;
      us8 o;
#pragma unroll
      for (int i = 0; i < 8; ++i) o[i] = f2bf(tile[(k8 * 8 + i) * 65 + n]);
      *(us8*)(dst + (size_t)(n0 + n) * K + k0 + k8 * 8) = o;
    }
    __syncthreads();
  }
}

__device__ void adaln_phase(const Params& p, int bid, int nblk, int tidx) {
  float* sc = (float*)g_smem;
  float* red = sc + 4096;
  float* mod = (float*)(G(p.ws) + OFF_MOD);
  const int tid = tidx;
  bool inited = false;
  for (int it = bid; it < 384; it += nblk) {
    if (!inited) {
      for (int k = tid; k < 2048; k += NTHREADS) {
        float a = G(p.c)[k], b = G(p.cctx)[k];
        sc[k] = a * sigmoidf_(a); sc[2048 + k] = b * sigmoidf_(b);
      }
      inited = true;
      __syncthreads();
    }
    const int i = it / 96, col0 = (it % 96) * 64;
    const int cg4 = tid & 15, ks = tid >> 4;
    float acc[8];
#pragma unroll
    for (int e = 0; e < 8; ++e) acc[e] = 0.f;
    const float* wp = G(p.ada_w) + (size_t)i * 2048 * 6144 + col0 + cg4 * 4;
#pragma unroll 4
    for (int kk = 0; kk < 64; ++kk) {
      const int k = kk * 32 + ks;
      f32x4 w = __builtin_nontemporal_load((const f32x4*)(wp + (size_t)k * 6144));
      const float s0 = sc[k], s1 = sc[2048 + k];
#pragma unroll
      for (int e = 0; e < 4; ++e) { acc[e] += w[e] * s0; acc[4 + e] += w[e] * s1; }
    }
#pragma unroll
    for (int e = 0; e < 8; ++e) red[(ks * 16 + cg4) * 8 + e] = acc[e];
    __syncthreads();
    if (tid < 128) {
      const int c4 = tid >> 3, v = tid & 7;
      float s = 0.f;
      for (int q = 0; q < 32; ++q) s += red[(q * 16 + c4) * 8 + v];
      const int which = v >> 2, col = col0 + c4 * 4 + (v & 3);
      mod[(i * 2 + which) * 6144 + col] = s + G(p.ada_b)[i * 6144 + col];
    }
    __syncthreads();
  }
}

__device__ __forceinline__ float wave_sum(float v) {
#pragma unroll
  for (int o = 32; o > 0; o >>= 1) v += __shfl_xor(v, o);
  return v;
}
__device__ __forceinline__ int perm_row(int layer, int l) { return (layer >= 2) ? ((l & 63) * 128 + (l >> 6)) : l; }

__device__ void norm_phase(const Params& p, int i, int bid, int nblk, int tidx) {
  const int tid = tidx, lane = tid & 63, wid = tid >> 6;
  const float* mod = (const float*)(G(p.ws) + OFF_MOD);
  float* xcur = (float*)(G(p.ws) + OFF_XCUR);
  const bf16_t* ox = (const bf16_t*)(G(p.ws) + OFF_OX);
  bf16_t* hx = (bf16_t*)(G(p.ws) + OFF_HX);
  for (int r = bid * 8 + wid; r < MROWS; r += nblk * 8) {
    const bool isctx = r < CTXL;
    const int l = r - CTXL;
    if (i == 4 && isctx) continue;
    const int which = isctx ? 1 : 0;
    const float* xs = (i <= 1) ? (isctx ? G(p.ctx) + (size_t)r * DM : G(p.x) + (size_t)l * DM) : xcur + (size_t)r * DM;
    f32x4 xv[8];
#pragma unroll
    for (int q = 0; q < 8; ++q) xv[q] = *(const f32x4*)(xs + (q * 64 + lane) * 4);
    if (i > 0) {
      const int orow = isctx ? r : CTXL + perm_row(i - 1, l);
      const bf16_t* os = ox + (size_t)orow * DM;
      f32x4 ov[8];
      float ss = 0.f;
#pragma unroll
      for (int q = 0; q < 8; ++q) {
        { const us4 t_ = *(const us4*)(os + (q * 64 + lane) * 4); ov[q] = (f32x4){bf2f(t_[0]), bf2f(t_[1]), bf2f(t_[2]), bf2f(t_[3])}; }
        ss += ov[q][0] * ov[q][0] + ov[q][1] * ov[q][1] + ov[q][2] * ov[q][2] + ov[q][3] * ov[q][3];
      }
      ss = wave_sum(ss);
      const float inv = rsqrtf(ss * (1.0f / DM) + 1e-6f);
      const float* gate = mod + ((i - 1) * 2 + which) * 6144 + 4096;
      const float* np = G(p.norm_post) + (i - 1) * DM;
#pragma unroll
      for (int q = 0; q < 8; ++q) {
        const int col = (q * 64 + lane) * 4;
        f32x4 gv = *(const f32x4*)(gate + col), nv = *(const f32x4*)(np + col);
#pragma unroll
        for (int e = 0; e < 4; ++e) xv[q][e] += gv[e] * (ov[q][e] * inv * nv[e]);
      }
      float* xd = (i == 4) ? G(p.out) + (size_t)l * DM : xcur + (size_t)r * DM;
#pragma unroll
      for (int q = 0; q < 8; ++q) *(f32x4*)(xd + (q * 64 + lane) * 4) = xv[q];
    }
    if (i < 4) {
      float ss = 0.f;
#pragma unroll
      for (int q = 0; q < 8; ++q) ss += xv[q][0] * xv[q][0] + xv[q][1] * xv[q][1] + xv[q][2] * xv[q][2] + xv[q][3] * xv[q][3];
      ss = wave_sum(ss);
      const float inv = rsqrtf(ss * (1.0f / DM) + 1e-6f);
      const float* shift = mod + (i * 2 + which) * 6144;
      const float* scale = shift + 2048;
      const float* np = G(p.norm_pre) + i * DM;
      const int hrow = isctx ? r : CTXL + perm_row(i, l);
      bf16_t* hd = hx + (size_t)hrow * DM;
#pragma unroll
      for (int q = 0; q < 8; ++q) {
        const int col = (q * 64 + lane) * 4;
        f32x4 sh = *(const f32x4*)(shift + col), scv = *(const f32x4*)(scale + col), nv = *(const f32x4*)(np + col);
        us4 o;
#pragma unroll
        for (int e = 0; e < 4; ++e) o[e] = f2bf((xv[q][e] * inv) * nv[e] * (1.0f + scv[e]) + sh[e]);
        *(us4*)(hd + col) = o;
      }
    }
  }
}

constexpr int BM = 256, BK = 64, HALF = 128, NXCD = 8, WGM = 4, HT = HALF * BK;

__device__ __forceinline__ int lds_byte(int r, int c) {
  int st = (r >> 4) * 2 + (c >> 5), rr = r & 15, cc = c & 31, ob = rr * 64 + cc * 2;
  return st * 1024 + (ob ^ (((ob >> 9) & 1) << 5));
}
__device__ __forceinline__ void stage_rc(int b, int& R, int& C) {
  int st = b / 1024, sb = b % 1024, swz = sb ^ (((sb >> 9) & 1) << 5);
  R = (st >> 1) * 16 + swz / 64; C = (st & 1) * 32 + (swz % 64) / 2;
}

struct EpiAny {
  int mode; void* O; int ld; const bf16_t* yg; const bf16_t* z; int ldz; const float* bias;
  __device__ __forceinline__ void operator()(const f32x4 (&acc)[2][2][4][2], int brow, int bcol, int wr, int wc, int fr, int fq) const {
    if (mode == 0) {
      bf16_t* Ob = (bf16_t*)O;
      const int lane_ = fr + 16 * fq, wid_ = wr * 4 + wc;
      unsigned char __attribute__((address_space(3)))* tb = (unsigned char __attribute__((address_space(3)))*)g_smem + 131072 + wid_ * 2048;
#pragma unroll
      for (int ai = 0; ai < 2; ++ai)
#pragma unroll
        for (int bj = 0; bj < 2; ++bj)
#pragma unroll
          for (int hh = 0; hh < 2; ++hh) {
#pragma unroll
            for (int mm = 0; mm < 2; ++mm)
#pragma unroll
              for (int n = 0; n < 2; ++n) {
                const f32x4 v = acc[ai][bj][hh * 2 + mm][n];
                unsigned __attribute__((ext_vector_type(2))) o2;
                o2[0] = cvt_pk_bf16(v[0], v[1]); o2[1] = cvt_pk_bf16(v[2], v[3]);
                *(unsigned __attribute__((ext_vector_type(2))) __attribute__((address_space(3)))*)(tb + (mm * 16 + fr) * 64 + (((n * 16 + fq * 4) * 2) ^ (((fr >> 1) & 3) << 4))) = o2;
              }
#pragma unroll
            for (int ps = 0; ps < 2; ++ps) {
              const int rr = ps * 16 + (lane_ >> 2);
              const us8 o = *(const us8 __attribute__((address_space(3)))*)(tb + rr * 64 + (((lane_ & 3) * 16) ^ (((rr >> 1) & 3) << 4)));
              const int row = brow + ai * HALF + wr * 64 + hh * 32 + rr;
              const int col = bcol + bj * HALF + wc * 32 + (lane_ & 3) * 8;
              *(us8*)(Ob + (size_t)row * ld + col) = o;
            }
          }
    } else {
      const int lane_ = fr + 16 * fq, wid_ = wr * 4 + wc;
      unsigned char __attribute__((address_space(3)))* tb = (unsigned char __attribute__((address_space(3)))*)g_smem + 131072 + wid_ * 2048;
      const int rr = lane_ >> 2, g0 = (lane_ & 3) * 2;
#pragma unroll
      for (int ai = 0; ai < 2; ++ai)
#pragma unroll
        for (int bj = 0; bj < 2; ++bj)
#pragma unroll
          for (int m = 0; m < 4; ++m) {
#pragma unroll
            for (int n = 0; n < 2; ++n)
              *(f32x4 __attribute__((address_space(3)))*)(tb + fr * 128 + (((n * 4 + fq) ^ (fr & 7)) << 4)) = acc[ai][bj][m][n];
            const f32x4 s0 = *(const f32x4 __attribute__((address_space(3)))*)(tb + rr * 128 + (((g0) ^ (rr & 7)) << 4));
            const f32x4 s1 = *(const f32x4 __attribute__((address_space(3)))*)(tb + rr * 128 + (((g0 + 1) ^ (rr & 7)) << 4));
            const int row = brow + ai * HALF + wr * 64 + m * 16 + rr;
            const int col = bcol + bj * HALF + wc * 32 + (lane_ & 3) * 8;
            if (mode == 1) {
              float* op = (float*)O + (size_t)row * ld + col;
              *(f32x4*)op = s0; *(f32x4*)(op + 4) = s1;
            } else {
              const us8 yv = *(const us8*)(yg + (size_t)row * EI + col);
              const us8 zv = *(const us8*)(z + (size_t)row * ldz + col);
              const f32x4 b0 = *(const f32x4*)(bias + col), b1 = *(const f32x4*)(bias + col + 4);
              u32x4 o;
#pragma unroll
              for (int e = 0; e < 4; ++e) {
                const float a0 = (e < 2 ? s0[2 * e] + b0[2 * e] : s1[2 * e - 4] + b1[2 * e - 4]);
                const float a1 = (e < 2 ? s0[2 * e + 1] + b0[2 * e + 1] : s1[2 * e - 3] + b1[2 * e - 3]);
                const float y0 = bf2f(yv[2 * e]), y1 = bf2f(yv[2 * e + 1]), z0 = bf2f(zv[2 * e]), z1 = bf2f(zv[2 * e + 1]);
                o[e] = cvt_pk_bf16(y0 * sigmoidf_(a0) * (z0 * sigmoidf_(z0)), y1 * sigmoidf_(a1) * (z1 * sigmoidf_(z1)));
              }
              *(u32x4*)((bf16_t*)O + (size_t)row * EI + col) = o;
            }
          }
    }
  }
};

#define LAS __attribute__((address_space(3)))
struct Unit { int pm, pn; };
struct TileOrder {
  int nM, nN, nwg, G, c;
  __device__ __forceinline__ bool next(int i, Unit& u) const {
    const long L = (long)i * G + c; if (L >= nwg) return false;
    int wgid = (int)L; { const int q = nwg / NXCD, r = nwg % NXCD, xcd = wgid % NXCD, off = wgid / NXCD; wgid = (xcd < r ? xcd * (q + 1) : r * (q + 1) + (xcd - r) * q) + off; }
    const int nig = WGM * nN, gid = wgid / nig, fm = gid * WGM, gsz = (nM - fm) < WGM ? (nM - fm) : WGM;
    u.pm = fm + ((wgid % nig) % gsz); u.pn = (wgid % nig) / gsz; return true;
  }
};
constexpr int HTB = HALF * BK * 2;

__device__ __forceinline__ EpiAny make_epi(const Params& p, int s, int is_s5, int j) {
  EpiAny e{};
  bf16_t* P = (bf16_t*)(G(p.ws) + OFF_P);
  if (s == 1) { e.mode = 0; e.O = P; e.ld = is_s5 ? 8192 : 20480; }
  else if (s == 3) { e.mode = 2; e.O = G(p.ws) + OFF_V; e.ld = EI; e.yg = (const bf16_t*)(G(p.ws) + OFF_YG); e.z = P + 4096; e.ldz = 8192; e.bias = G(p.s5_b_glu) + (size_t)j * EI; }
  else { e.mode = 0; e.O = G(p.ws) + OFF_OX; e.ld = DM; }
  return e;
}
__device__ __forceinline__ void gemm_phase(const bf16_t* __restrict__ A, const bf16_t* __restrict__ Bt, int M, int N, int K, const Params& p, int es, int eis5, int ej, int bid, int nblk, int tidx) {
  LAS unsigned char* lds = (LAS unsigned char*)g_smem;
  TileOrder S; S.nM = M / BM; S.nN = N / BM; S.nwg = S.nM * S.nN; S.G = nblk; S.c = bid;
  const int tid = tidx, wid = __builtin_amdgcn_readfirstlane(tid >> 6), lane = tid & 63, wr = wid >> 2, wc = wid & 3, fr = lane & 15, fq = lane >> 4;
  const int nt = K / BK;
  unsigned voffA[2];
#pragma unroll
  for (int i = 0; i < 2; ++i) { int R, C; stage_rc(tid * 16 + i * 8192, R, C); voffA[i] = (unsigned)(R * K + C) * 2u; }
  const size_t kstep = (size_t)(BK * 2);
  const size_t hstep = (size_t)HALF * K * 2;
  const size_t tstep = 2 * hstep;
  const unsigned ldsw = (unsigned)wid * 1024u;
  const int aoff = lds_byte(wr * 64 + fr, fq * 8), boff = lds_byte(wc * 32 + fr, fq * 8);
#define G_SA(b, h) (((b) * 2 + (h)) * HTB)
#define G_SB(b, h) ((4 + (b) * 2 + (h)) * HTB)
#define G_STAGE(bufoff, gbase) do { _Pragma("unroll") for (int _i = 0; _i < 2; ++_i) \
    __builtin_amdgcn_global_load_lds((const unsigned*)((const char*)(gbase) + voffA[_i]), (LAS unsigned*)(lds + (bufoff) + ldsw + _i * 8192), 16, 0, 0); } while (0)
#define G_LDA(dst, b, h) do { _Pragma("unroll") for (int m = 0; m < 4; ++m) _Pragma("unroll") for (int k = 0; k < 2; ++k) dst[m][k] = *(const LAS bf16x8*)(lds + G_SA(b, h) + aoff + m * 2048 + k * 1024); } while (0)
#define G_LDB(dst, b, h) do { _Pragma("unroll") for (int n = 0; n < 2; ++n) _Pragma("unroll") for (int k = 0; k < 2; ++k) dst[n][k] = *(const LAS bf16x8*)(lds + G_SB(b, h) + boff + n * 2048 + k * 1024); } while (0)
#define G_MMA(ai, bj, At_, Bt_) do { __builtin_amdgcn_s_setprio(1); _Pragma("unroll") for (int m = 0; m < 4; ++m) _Pragma("unroll") for (int n = 0; n < 2; ++n) _Pragma("unroll") for (int k = 0; k < 2; ++k) \
    acc[ai][bj][m][n] = __builtin_amdgcn_mfma_f32_16x16x32_bf16(Bt_[n][k], At_[m][k], acc[ai][bj][m][n], 0, 0, 0); __builtin_amdgcn_s_setprio(0); } while (0)
#define G_WAIT_V(n) asm volatile("s_waitcnt vmcnt(" #n ")" ::: "memory")
#define G_WAIT_L(n) asm volatile("s_waitcnt lgkmcnt(" #n ")" ::: "memory")
#define G_BAR __builtin_amdgcn_s_barrier()
#define G_SCHED __builtin_amdgcn_sched_barrier(0)
  Unit cur, nxt; int ui = 0;
  __syncthreads();
  if (!S.next(0, cur)) return;
  f32x4 acc[2][2][4][2];
#pragma unroll
  for (int a = 0; a < 2; ++a)
#pragma unroll
    for (int b = 0; b < 2; ++b)
#pragma unroll
      for (int m = 0; m < 4; ++m)
#pragma unroll
        for (int n = 0; n < 2; ++n) acc[a][b][m][n] = (f32x4){0.f, 0.f, 0.f, 0.f};
  bf16x8 At[4][2], B0[2][2], B1[2][2];
  const char* cA = (const char*)A + (size_t)cur.pm * tstep; const char* cB = (const char*)Bt + (size_t)cur.pn * tstep;
  G_STAGE(G_SB(0, 0), cB); G_STAGE(G_SA(0, 0), cA); G_STAGE(G_SB(0, 1), cB + hstep); G_STAGE(G_SA(0, 1), cA + hstep);
  if (wr == 1) G_BAR;
  G_WAIT_V(4); G_BAR;
  G_STAGE(G_SB(1, 0), cB + kstep); G_STAGE(G_SA(1, 0), cA + kstep); G_STAGE(G_SB(1, 1), cB + hstep + kstep);
  G_WAIT_V(6); G_BAR;
  for (;;) {
    const bool has_next = S.next(ui + 1, nxt);
    const char* nA = has_next ? (const char*)A + (size_t)nxt.pm * tstep : cA; const char* nB = has_next ? (const char*)Bt + (size_t)nxt.pn * tstep : cB;
    for (int t = 0; t < nt; t += 2) {
      const bool last = (t == nt - 2);
      const char* a1 = cA + (size_t)(t + 1) * kstep;
      const char* a2 = last ? nA : cA + (size_t)(t + 2) * kstep; const char* b2 = last ? nB : cB + (size_t)(t + 2) * kstep;
      const char* a3 = a2 + kstep; const char* b3 = b2 + kstep;
      G_LDB(B0, 0, 0); G_SCHED; G_LDA(At, 0, 0); G_STAGE(G_SA(1, 1), a1 + hstep);
      G_WAIT_L(8); G_BAR; G_WAIT_L(0); G_MMA(0, 0, At, B0); G_BAR; G_SCHED;
      G_LDB(B1, 0, 1); G_STAGE(G_SB(0, 0), b2);
      G_BAR; G_WAIT_L(0); G_MMA(0, 1, At, B1); G_BAR;
      G_LDA(At, 0, 1); G_STAGE(G_SA(0, 0), a2);
      G_BAR; G_WAIT_L(0); G_MMA(1, 0, At, B0); G_BAR; G_SCHED;
      G_STAGE(G_SB(0, 1), b2 + hstep);
      G_WAIT_V(6); G_BAR; G_MMA(1, 1, At, B1); G_BAR;
      G_LDB(B0, 1, 0); G_SCHED; G_LDA(At, 1, 0); G_STAGE(G_SA(0, 1), a2 + hstep);
      G_WAIT_L(8); G_BAR; G_WAIT_L(0); G_MMA(0, 0, At, B0); G_BAR; G_SCHED;
      G_LDB(B1, 1, 1); G_STAGE(G_SB(1, 0), b3);
      G_BAR; G_WAIT_L(0); G_MMA(0, 1, At, B1); G_BAR;
      G_LDA(At, 1, 1); G_STAGE(G_SA(1, 0), a3);
      G_BAR; G_WAIT_L(0); G_MMA(1, 0, At, B0); G_BAR; G_SCHED;
      G_STAGE(G_SB(1, 1), b3 + hstep);
      G_WAIT_V(6); G_BAR; G_MMA(1, 1, At, B1); G_BAR;
    }
    {
      int es_ = es; asm volatile("" : "+s"(es_));
      const EpiAny E = make_epi(p, es_, eis5, ej);
      E(acc, cur.pm * BM + (eis5 || es_ != 1 ? CTXL : 0), cur.pn * BM, wr, wc, fr, fq);
    }
    if (!has_next) break;
#pragma unroll
    for (int a = 0; a < 2; ++a)
#pragma unroll
      for (int b = 0; b < 2; ++b)
#pragma unroll
        for (int m = 0; m < 4; ++m)
#pragma unroll
          for (int n = 0; n < 2; ++n) acc[a][b][m][n] = (f32x4){0.f, 0.f, 0.f, 0.f};
    cur = nxt; cA = nA; cB = nB; ++ui;
  }
  G_WAIT_V(0);
  if (wr == 0) G_BAR;
  G_BAR;
#undef G_SA
#undef G_SB
#undef G_STAGE
#undef G_LDA
#undef G_LDB
#undef G_MMA
}

#define MFMA16(a, b, c) __builtin_amdgcn_mfma_f32_16x16x32_bf16(a, b, c, 0, 0, 0)
__device__ __forceinline__ void gemm_small_phase(const bf16_t* __restrict__ A, const bf16_t* __restrict__ Bt, int N, int K, const Params& p, int es, int eis5, int ej, int bid, int nblk, int tidx) {
  float* part = (float*)g_smem;
  const int tid = tidx, lane = tid & 63, wid = tid >> 6, fr = lane & 15, fq = lane >> 4;
  const int nsn = N >> 6;
  const int kw = K >> 3, nkb = kw >> 7;
#pragma unroll 1
  for (int u = bid; ; u += nblk) {
    const int b_ = u % nblk, k_ = u / nblk;
    int sm, sn;
    if ((nblk & 255) == 0) { const int b8 = b_ & 255; sm = (b8 >> 3) & 3; sn = (b8 & 7) + 8 * (b8 >> 5) + 64 * ((b_ >> 8) + (nblk >> 8) * k_); }
    else { sm = u & 3; sn = u >> 2; }
    if (sn >= nsn) { if ((nblk & 255) == 0 ? (64 * (nblk >> 8) * k_ >= nsn) : true) break; else continue; }
    f32x4 acc[4][4];
#pragma unroll
    for (int a = 0; a < 4; ++a)
#pragma unroll
      for (int b = 0; b < 4; ++b) acc[a][b] = (f32x4){0.f, 0.f, 0.f, 0.f};
    const bf16_t* ap = A + (size_t)(sm * 64 + (lane >> 2)) * K + wid * kw + (lane & 3) * 8;
    const bf16_t* bp = Bt + (size_t)(sn * 64 + (lane >> 2)) * K + wid * kw + (lane & 3) * 8;
    const int bsrc = (4 * fr + fq) * 4;
#pragma unroll 1
    for (int kb = 0; kb < nkb; ++kb) {
      bf16x8 af[4][4], bf[4][4];
      {
        u32x4 ra[4][4], rb[4][4];
#pragma unroll
        for (int ks = 0; ks < 4; ++ks)
#pragma unroll
          for (int i = 0; i < 4; ++i) {
            ra[ks][i] = *(const u32x4*)(ap + (size_t)i * 16 * K + kb * 128 + ks * 32);
            rb[ks][i] = *(const u32x4*)(bp + (size_t)i * 16 * K + kb * 128 + ks * 32);
          }
        __builtin_amdgcn_sched_barrier(0);
#pragma unroll
        for (int ks = 0; ks < 4; ++ks)
#pragma unroll
          for (int i = 0; i < 4; ++i) {
            u32x4 ta, tb;
#pragma unroll
            for (int w4 = 0; w4 < 4; ++w4) {
              ta[w4] = (unsigned)__builtin_amdgcn_ds_bpermute(bsrc, (int)ra[ks][i][w4]);
              tb[w4] = (unsigned)__builtin_amdgcn_ds_bpermute(bsrc, (int)rb[ks][i][w4]);
            }
            af[ks][i] = __builtin_bit_cast(bf16x8, ta); bf[ks][i] = __builtin_bit_cast(bf16x8, tb);
          }
      }
#pragma unroll
      for (int ks = 0; ks < 4; ++ks)
#pragma unroll
        for (int mi = 0; mi < 4; ++mi)
#pragma unroll
          for (int ni = 0; ni < 4; ++ni) acc[mi][ni] = MFMA16(bf[ks][ni], af[ks][mi], acc[mi][ni]);
    }
    __syncthreads();
#pragma unroll
    for (int mi = 0; mi < 4; ++mi)
#pragma unroll
      for (int ni = 0; ni < 4; ++ni) *(f32x4*)(part + (wid * 64 + mi * 16 + fr) * 68 + ni * 16 + fq * 4) = acc[mi][ni];
    __syncthreads();
    {
      const int rl = tid >> 3, c0 = (tid & 7) * 8;
      f32x4 s0 = (f32x4){0.f, 0.f, 0.f, 0.f}, s1 = s0;
#pragma unroll
      for (int w = 0; w < 8; ++w) { s0 += *(const f32x4*)(part + (w * 64 + rl) * 68 + c0); s1 += *(const f32x4*)(part + (w * 64 + rl) * 68 + c0 + 4); }
      const int row = sm * 64 + rl, col = sn * 64 + c0;
      bf16_t* Pp = (bf16_t*)(G(p.ws) + OFF_P);
      if (es == 1) {
        const int ld = eis5 ? 8192 : 20480;
        us8 o;
#pragma unroll
        for (int e = 0; e < 4; ++e) { o[e] = f2bf(s0[e]); o[4 + e] = f2bf(s1[e]); }
        *(us8*)(Pp + (size_t)row * ld + col) = o;
      } else if (es == 3) {
        const us8 yv = *(const us8*)((const bf16_t*)(G(p.ws) + OFF_YG) + (size_t)row * EI + col);
        const us8 zv = *(const us8*)(Pp + (size_t)row * 8192 + 4096 + col);
        const float* bias = G(p.s5_b_glu) + (size_t)ej * EI + col;
        const f32x4 b0 = *(const f32x4*)bias, b1 = *(const f32x4*)(bias + 4);
        us8 o;
#pragma unroll
        for (int e = 0; e < 8; ++e) {
          const float a = (e < 4 ? s0[e & 3] : s1[e & 3]) + (e < 4 ? b0[e & 3] : b1[e & 3]);
          const float y = bf2f(yv[e]), zz = bf2f(zv[e]);
          o[e] = f2bf(y * sigmoidf_(a) * (zz * sigmoidf_(zz)));
        }
        *(us8*)((bf16_t*)(G(p.ws) + OFF_V) + (size_t)row * EI + col) = o;
      } else {
        u32x4 o;
        o[0] = cvt_pk_bf16(s0[0], s0[1]); o[1] = cvt_pk_bf16(s0[2], s0[3]); o[2] = cvt_pk_bf16(s1[0], s1[1]); o[3] = cvt_pk_bf16(s1[2], s1[3]);
        *(u32x4*)((bf16_t*)(G(p.ws) + OFF_OX) + (size_t)row * DM + col) = o;
      }
    }
  }
  __syncthreads();
}

#define S5_NG 48
#define S5_USTR 1040
#define S5_HSTR 528

__device__ __forceinline__ float gelu_as(float v) {
  const float av = fabsf(v), t = __builtin_amdgcn_rcpf(av * 0.2316418882f + 1.0f);
  float q = t * 0.5307027145f + (-0.7265760135f); q = q * t + 0.7107068705f; q = q * t + (-0.142248368f); q = q * t + 0.127414796f; q = q * t;
  const float e = __builtin_amdgcn_exp2f((v * v) * (-0.72134752044f));
  const float m = v * (q * e);
  return v < 0.f ? m : v - m;
}
__device__ __forceinline__ unsigned pk_bf16(float lo, float hi) { return cvt_pk_bf16(lo, hi); }

__device__ void s5_phase(const Params& p, int j, int bid, int nblk, int tidx) {
  bf16_t* KcL = (bf16_t*)g_smem;
  float* pw = (float*)(g_smem + 32768);
  float* cc = pw + 2 * 33 * 64 * 2;
  unsigned char* UL = g_smem + 83200;
  unsigned char* HL = UL + 32 * S5_USTR;
  float* bbar = (float*)(g_smem + 133376);
#define S5P ((const bf16_t*)(G(p.ws) + OFF_P))
#define S5YG ((bf16_t*)(G(p.ws) + OFF_YG))
#pragma unroll 1
  for (int gi = bid; gi < 256; gi += nblk) {
    const int g = (gi & 7) * 32 + (gi >> 3);
    int tid = tidx; asm volatile("" : "+v"(tid));
    const int lane = tid & 63, wid = tid >> 6, fr = lane & 15, fq = lane >> 4;
#define S5S ((float*)(G(p.ws) + OFF_S5SCR + (size_t)g * S5_PER + S5_S))
#define S5HB ((bf16_t*)(G(p.ws) + OFF_S5SCR + (size_t)g * S5_PER + S5_H))
#define S5_TABLES() do { \
      for (int idx = tid; idx < 2 * 33 * 64; idx += NTHREADS) { \
        const int d_ = idx / (33 * 64), m_ = (idx >> 6) % 33, pp_ = idx & 63; \
        const size_t gi_ = ((size_t)(j * 2 + d_) * 256 + g); \
        const float lr_ = G(p.s5_lam_re)[gi_ * 64 + pp_], li_ = G(p.s5_lam_im)[gi_ * 64 + pp_]; \
        const float dt_ = expf(G(p.s5_log_dt)[gi_]); \
        const float mag_ = expf(lr_ * dt_ * (float)m_); \
        double rv_ = (double)li_ * (double)dt_ * 0.15915494309189535 * (double)m_; rv_ -= rint(rv_); \
        pw[idx * 2 + 0] = mag_ * __builtin_amdgcn_cosf((float)rv_); \
        pw[idx * 2 + 1] = mag_ * __builtin_amdgcn_sinf((float)rv_); } \
      for (int e_ = tid; e_ < 2 * 16 * 64; e_ += NTHREADS) { \
        const int d_ = e_ >> 10, c_ = (e_ >> 6) & 15, pp_ = e_ & 63; \
        const size_t ci_ = (((size_t)(j * 2 + d_) * 256 + g) * 16 + c_) * 64 + pp_; \
        cc[((d_ * 16 + c_) * 65 + pp_) * 2 + 0] = G(p.s5_c_re)[ci_]; cc[((d_ * 16 + c_) * 65 + pp_) * 2 + 1] = G(p.s5_c_im)[ci_]; } \
    } while (0)
    __syncthreads();
    S5_TABLES();
    __syncthreads();
    for (int e = tid; e < 2 * 64 * 16; e += NTHREADS) {
      const int d = e >> 10, pp = (e >> 4) & 63, c = e & 15;
      const size_t gi = ((size_t)(j * 2 + d) * 256 + g);
      const float lr = G(p.s5_lam_re)[gi * 64 + pp], li = G(p.s5_lam_im)[gi * 64 + pp];
      const float ar1 = pw[((d * 33 + 1) * 64 + pp) * 2], ai1 = pw[((d * 33 + 1) * 64 + pp) * 2 + 1];
      const float den = lr * lr + li * li;
      const float qr = ((ar1 - 1.0f) * lr + ai1 * li) / den;
      const float qi = (ai1 * lr - (ar1 - 1.0f) * li) / den;
      const float b_r = G(p.s5_b_re)[(gi * 64 + pp) * 16 + c], b_i = G(p.s5_b_im)[(gi * 64 + pp) * 16 + c];
      bbar[e * 2 + 0] = qr * b_r - qi * b_i;
      bbar[e * 2 + 1] = qr * b_i + qi * b_r;
    }
    __syncthreads();
    {
#pragma unroll 1
      for (int a = 0; a < 4; ++a) {
        const int tau = wid * 4 + a;
        f32x4 acc = (f32x4){0.f, 0.f, 0.f, 0.f};
#pragma unroll
        for (int d = 0; d < 2; ++d) {
#pragma unroll
          for (int ks = 0; ks < 4; ++ks) {
            const int p0 = ks * 16 + fq * 4;
            u32x4 afu, bfu;
#pragma unroll
            for (int i = 0; i < 4; ++i) {
              const float cr = cc[((d * 16 + fr) * 65 + p0 + i) * 2], ci = cc[((d * 16 + fr) * 65 + p0 + i) * 2 + 1];
              const float pr = pw[((d * 33 + tau) * 64 + p0 + i) * 2], pi = pw[((d * 33 + tau) * 64 + p0 + i) * 2 + 1];
              afu[i] = pk_bf16(cr * pr - ci * pi, -(cr * pi + ci * pr));
              bfu[i] = pk_bf16(bbar[((d * 64 + p0 + i) * 16 + fr) * 2], bbar[((d * 64 + p0 + i) * 16 + fr) * 2 + 1]);
            }
            acc = MFMA16(__builtin_bit_cast(bf16x8, afu), __builtin_bit_cast(bf16x8, bfu), acc);
          }
          if (tau != 0 || d == 1) {
            const int dl = (tau == 0) ? 0 : (d ? -tau : tau);
#pragma unroll
            for (int r = 0; r < 4; ++r) KcL[((dl + 31) * 16 + fq * 4 + r) * 16 + fr] = f2bf(acc[r]);
            acc = (f32x4){0.f, 0.f, 0.f, 0.f};
          }
        }
      }
    }
    float atr2[2][2];
    { const int dp = tid & 127; atr2[0][0] = atr2[1][0] = pw[(((dp >> 6) * 33 + 32) * 64 + (dp & 63)) * 2]; atr2[0][1] = atr2[1][1] = pw[(((dp >> 6) * 33 + 32) * 64 + (dp & 63)) * 2 + 1]; }
    {
      u32x4 w1f[2][16];
#pragma unroll
      for (int a = 0; a < 2; ++a) {
        const int R = (wid * 2 + a) * 16 + fr, dR = R >> 7, pp = (R & 127) >> 1, ri = R & 1;
        float br[8], bi[8];
#pragma unroll
        for (int i = 0; i < 8; ++i) { br[i] = bbar[((dR * 64 + pp) * 16 + (fq & 1) * 8 + i) * 2]; bi[i] = bbar[((dR * 64 + pp) * 16 + (fq & 1) * 8 + i) * 2 + 1]; }
#pragma unroll
        for (int ks = 0; ks < 16; ++ks) {
          const int s = ks * 2 + (fq >> 1), e = dR ? s : (31 - s);
          const float pr = pw[((dR * 33 + e) * 64 + pp) * 2], pi = pw[((dR * 33 + e) * 64 + pp) * 2 + 1];
#pragma unroll
          for (int i = 0; i < 4; ++i) {
            const float lo = ri ? (pr * bi[2 * i] + pi * br[2 * i]) : (pr * br[2 * i] - pi * bi[2 * i]);
            const float hi = ri ? (pr * bi[2 * i + 1] + pi * br[2 * i + 1]) : (pr * br[2 * i + 1] - pi * bi[2 * i + 1]);
            w1f[a][ks][i] = pk_bf16(lo, hi);
          }
          __builtin_amdgcn_sched_barrier(0);
        }
      }
      __syncthreads();
      us8 pu[4];
#define S5_ULOADX(ngx, R_) do { _Pragma("unroll") for (int i = 0; i < 4; ++i) { \
          const int piece = tid + NTHREADS * i, half = piece & 1, s = (piece >> 1) & 31, chl = piece >> 6; \
          const int ch = min((ngx) * 32 + chl, 263); \
          R_[i] = *(const us8*)(S5P + (size_t)(ch * 32 + s) * 8192 + g * 16 + half * 8); } } while (0)
#define S5_USTOREX(R_) do { _Pragma("unroll") for (int i = 0; i < 4; ++i) { \
          const int piece = tid + NTHREADS * i, half = piece & 1, s = (piece >> 1) & 31, chl = piece >> 6; \
          *(us8*)(UL + chl * S5_USTR + s * 32 + half * 16) = R_[i]; } } while (0)
#define S5_ULOAD(ngx) S5_ULOADX(ngx, pu)
#define S5_USTORE() S5_USTOREX(pu)
#define S5_STEP4(ng_, RC_) do { \
        S5_USTOREX(RC_); \
        __syncthreads(); \
        if ((ng_) + 1 < 9) S5_ULOADX((ng_) + 1, RC_); \
        f32x4 acc[2][2]; \
        _Pragma("unroll") for (int a = 0; a < 2; ++a) _Pragma("unroll") for (int q = 0; q < 2; ++q) acc[a][q] = (f32x4){0.f, 0.f, 0.f, 0.f}; \
        _Pragma("unroll") for (int ks = 0; ks < 16; ++ks) { \
          bf16x8 bf[2]; \
          _Pragma("unroll") for (int q = 0; q < 2; ++q) bf[q] = *(const bf16x8*)(UL + (q * 16 + fr) * S5_USTR + (ks * 2 + (fq >> 1)) * 32 + (fq & 1) * 16); \
          _Pragma("unroll") for (int a = 0; a < 2; ++a) _Pragma("unroll") for (int q = 0; q < 2; ++q) acc[a][q] = MFMA16(__builtin_bit_cast(bf16x8, w1f[a][ks]), bf[q], acc[a][q]); } \
        _Pragma("unroll") for (int a = 0; a < 2; ++a) _Pragma("unroll") for (int q = 0; q < 2; ++q) { \
            const int ch = (ng_) * 32 + q * 16 + fr; \
            if (ch < 264) *(f32x4*)(S5S + (size_t)ch * 256 + (wid * 2 + a) * 16 + fq * 4) = acc[a][q]; } \
        __syncthreads(); } while (0)
      S5_ULOADX(0, pu);
#pragma unroll 1
      for (int ng = 0; ng < 9; ++ng) { S5_STEP4(ng, pu); }
    }
    __syncthreads();
    {
      float* segend = (float*)UL;
      float* carry = segend + 8 * 128 * 2;
#pragma unroll 1
      for (int r = 0; r < 2; ++r) {
        const int item = tid + NTHREADS * r, dp = item & 127, d = dp >> 6, seg = item >> 7;
        const float* Sp = S5S + d * 128 + 2 * (dp & 63);
        float sr[33], si[33];
#pragma unroll
        for (int q = 0; q < 33; ++q) {
          const int pos = seg * 33 + q, k = d ? (pos < 8 ? 7 - pos : 271 - pos) : pos;
          sr[q] = Sp[(size_t)k * 256]; si[q] = Sp[(size_t)k * 256 + 1];
        }
        float hr = 0.f, hi = 0.f;
        const float ar = atr2[0][0], ai = atr2[0][1];
#pragma unroll
        for (int q = 0; q < 33; ++q) {
          const float nr = ar * hr - ai * hi + sr[q], ni = ar * hi + ai * hr + si[q];
          hr = nr; hi = ni;
        }
        segend[(seg * 128 + dp) * 2] = hr; segend[(seg * 128 + dp) * 2 + 1] = hi;
      }
      __syncthreads();
      if (tid < 128) {
        float pr = atr2[0][0], pi = atr2[0][1];
        float p2r = pr, p2i = pi;
#pragma unroll
        for (int q = 0; q < 5; ++q) { const float t = p2r * p2r - p2i * p2i; p2i = 2.f * p2r * p2i; p2r = t; }
        const float Ar = p2r * pr - p2i * pi, Ai = p2r * pi + p2i * pr;
        float cr = 0.f, ci = 0.f;
#pragma unroll
        for (int j = 0; j < 8; ++j) {
          carry[(j * 128 + tid) * 2] = cr; carry[(j * 128 + tid) * 2 + 1] = ci;
          const float er = segend[(j * 128 + tid) * 2], ei = segend[(j * 128 + tid) * 2 + 1];
          const float nr = Ar * cr - Ai * ci + er, ni = Ar * ci + Ai * cr + ei;
          cr = nr; ci = ni;
        }
      }
      __syncthreads();
#pragma unroll 1
      for (int r = 0; r < 2; ++r) {
        const int item = tid + NTHREADS * r, dp = item & 127, d = dp >> 6, seg = item >> 7;
        const float* Sp = S5S + d * 128 + 2 * (dp & 63);
        bf16_t* Hp = S5HB + d * 128 + 2 * (dp & 63);
        float sr[33], si[33];
#pragma unroll
        for (int q = 0; q < 33; ++q) {
          const int pos = seg * 33 + q, k = d ? (pos < 8 ? 7 - pos : 271 - pos) : pos;
          sr[q] = Sp[(size_t)k * 256]; si[q] = Sp[(size_t)k * 256 + 1];
        }
        float hr = carry[(seg * 128 + dp) * 2], hi = carry[(seg * 128 + dp) * 2 + 1];
        const float ar = atr2[0][0], ai = atr2[0][1];
#pragma unroll
        for (int q = 0; q < 33; ++q) {
          const int pos = seg * 33 + q, k = d ? (pos < 8 ? 7 - pos : 271 - pos) : pos;
          *(unsigned*)(Hp + (size_t)k * 256) = pk_bf16(hr, hi);
          const float nr = ar * hr - ai * hi + sr[q], ni = ar * hi + ai * hr + si[q];
          hr = nr; hi = ni;
        }
      }
    }
    __syncthreads();
#pragma unroll 1
    for (int half = 0; half < 2; ++half) {
      u32x4 w2f[2][8];
#pragma unroll
      for (int a = 0; a < 2; ++a) {
        const int t = wid * 4 + half * 2 + a;
#pragma unroll
        for (int kq = 0; kq < 8; ++kq) {
          const int d2 = kq >> 2, p0 = (kq & 3) * 16 + fq * 4, e = d2 ? (32 - t) : (t + 1);
#pragma unroll
          for (int i = 0; i < 4; ++i) {
            const float cr = cc[((d2 * 16 + fr) * 65 + p0 + i) * 2], ci = cc[((d2 * 16 + fr) * 65 + p0 + i) * 2 + 1];
            const float pr = pw[((d2 * 33 + e) * 64 + p0 + i) * 2], pi = pw[((d2 * 33 + e) * 64 + p0 + i) * 2 + 1];
            w2f[a][kq][i] = pk_bf16(cr * pr - ci * pi, -(cr * pi + ci * pr));
          }
          __builtin_amdgcn_sched_barrier(0);
        }
      }
      us8 pu[4], pv[4], phh[2], phv[2];
#define S5_HLOADX(ngx, R_) do { _Pragma("unroll") for (int i = 0; i < 2; ++i) { \
          const int piece = tid + NTHREADS * i, chl = piece >> 5, k8 = (piece & 31) * 8; \
          const int ch = min((ngx) * 32 + chl, 263); \
          R_[i] = *(const us8*)(S5HB + (size_t)ch * 256 + k8); } } while (0)
#define S5_HSTOREX(R_) do { _Pragma("unroll") for (int i = 0; i < 2; ++i) { \
          const int piece = tid + NTHREADS * i, chl = piece >> 5, k8 = (piece & 31) * 8; \
          *(us8*)(HL + chl * S5_HSTR + k8 * 2) = R_[i]; } } while (0)
#define S5_STEP6(ng_, RU_, RH_) do { \
        S5_USTOREX(RU_); S5_HSTOREX(RH_); \
        __syncthreads(); \
        if ((ng_) + 2 < 9) { S5_ULOADX((ng_) + 2, RU_); S5_HLOADX((ng_) + 2, RH_); } \
        f32x4 acc[2][2]; \
        _Pragma("unroll") for (int a = 0; a < 2; ++a) _Pragma("unroll") for (int q = 0; q < 2; ++q) acc[a][q] = (f32x4){0.f, 0.f, 0.f, 0.f}; \
        _Pragma("unroll 1") for (int ks = 0; ks < 16; ++ks) { \
          bf16x8 af[2], bf[2]; \
          const int s = ks * 2 + (fq >> 1); \
          _Pragma("unroll") for (int a = 0; a < 2; ++a) af[a] = *(const bf16x8*)(KcL + ((wid * 4 + half * 2 + a - s + 31) * 16 + fr) * 16 + (fq & 1) * 8); \
          _Pragma("unroll") for (int q = 0; q < 2; ++q) bf[q] = *(const bf16x8*)(UL + (q * 16 + fr) * S5_USTR + s * 32 + (fq & 1) * 16); \
          _Pragma("unroll") for (int a = 0; a < 2; ++a) _Pragma("unroll") for (int q = 0; q < 2; ++q) acc[a][q] = MFMA16(af[a], bf[q], acc[a][q]); } \
        _Pragma("unroll") for (int kq = 0; kq < 8; ++kq) { \
          bf16x8 bf[2]; \
          _Pragma("unroll") for (int q = 0; q < 2; ++q) bf[q] = *(const bf16x8*)(HL + (q * 16 + fr) * S5_HSTR + (kq * 32 + fq * 8) * 2); \
          _Pragma("unroll") for (int a = 0; a < 2; ++a) _Pragma("unroll") for (int q = 0; q < 2; ++q) acc[a][q] = MFMA16(__builtin_bit_cast(bf16x8, w2f[a][kq]), bf[q], acc[a][q]); } \
        const f32x4 dsk = *(const f32x4*)(G(p.s5_d) + (size_t)j * EI + g * 16 + fq * 4); \
        _Pragma("unroll") for (int a = 0; a < 2; ++a) _Pragma("unroll") for (int q = 0; q < 2; ++q) { \
            const int ch = (ng_) * 32 + q * 16 + fr; \
            if (ch < 264) { \
              const int t = wid * 4 + half * 2 + a; \
              const int row = ch * 32 + t; \
              const us4 uv = *(const us4*)(UL + (q * 16 + fr) * S5_USTR + t * 32 + fq * 8); \
              const float v0 = acc[a][q][0] + dsk[0] * bf2f(uv[0]); \
              const float v1 = acc[a][q][1] + dsk[1] * bf2f(uv[1]); \
              const float v2 = acc[a][q][2] + dsk[2] * bf2f(uv[2]); \
              const float v3 = acc[a][q][3] + dsk[3] * bf2f(uv[3]); \
              unsigned __attribute__((ext_vector_type(2))) o; \
              o[0] = cvt_pk_bf16(gelu_as(v0), gelu_as(v1)); o[1] = cvt_pk_bf16(gelu_as(v2), gelu_as(v3)); \
              *(unsigned __attribute__((ext_vector_type(2)))*)(S5YG + (size_t)row * EI + g * 16 + fq * 4) = o; } } \
        __syncthreads(); } while (0)
      S5_ULOADX(0, pu); S5_HLOADX(0, phh); S5_ULOADX(1, pv); S5_HLOADX(1, phv);
#pragma unroll 1
      for (int ng = 0; ng < 8; ng += 2) { S5_STEP6(ng, pu, phh); S5_STEP6(ng + 1, pv, phv); }
      S5_STEP6(8, pu, phh);
    }
#undef S5_TABLES
  }
}

__device__ __forceinline__ float fexp(float x) { return __expf(x); }
__device__ __forceinline__ float frcp(float x) { return __builtin_amdgcn_rcpf(x); }

__device__ void hgrn_pre_phase(const Params& p, int j, int bid, int nblk, int tidx) {
  const int tid = tidx, lane = tid & 63, wid = tid >> 6, fr = lane & 15, fq = lane >> 4;
  float* gbuf = (float*)g_smem;
  float* tot = gbuf + 64 * 128;
  float* cem = tot + 512;
  float* celm = cem + 128;
  bf16_t* qe = (bf16_t*)(celm + 128);
  bf16_t* ke = qe + 64 * 136;
  bf16_t* kbT = ke + 64 * 136;
  bf16_t* vT = kbT + 128 * 72;
  bf16_t* sc = vT + 128 * 72;
  bf16_t* P = (bf16_t*)(G(p.ws) + OFF_P);
  bf16_t* QB = (bf16_t*)(G(p.ws) + OFF_QB);
  bf16_t* VT = (bf16_t*)(G(p.ws) + OFF_VT);
  float* DEC = (float*)(G(p.ws) + OFF_DEC);
  const int tau = tid >> 3, dk0 = (tid & 7) * 16, swz = (tid & 7) * 8;
  us8 nf0, nf1, nq0, nq1, nv0, nv1;
  float lbv[16];
#pragma unroll
  for (int e = 0; e < 16; ++e) lbv[e] = 0.f;
  int cur_hd = -1;
  if (bid < 8448) {
    const int item = bid, d = item & 1, h = (item >> 1) & 31, chunk = item >> 6;
    const size_t row = (size_t)chunk * 64 + (d ? 63 - tau : tau);
    const bf16_t* rp = P + row * 20480 + h * 128 + dk0;
    nf0 = *(const us8*)(rp + (1 + d) * EI); nf1 = *(const us8*)(rp + (1 + d) * EI + 8);
    nq0 = *(const us8*)(rp + 3 * EI); nq1 = *(const us8*)(rp + 3 * EI + 8);
    nv0 = *(const us8*)(rp); nv1 = *(const us8*)(rp + 8);
  }
#pragma unroll 1
  for (int item = bid; item < 8448; item += nblk) {
    const int d = item & 1, h = (item >> 1) & 31, chunk = item >> 6;
    bf16_t* O = (bf16_t*)(G(p.ws) + OFF_OFB) + (size_t)d * MROWS * EI;
    float kk[16], qq[16];
    {
      const us8 cf0 = nf0, cf1 = nf1, cq0 = nq0, cq1 = nq1, cv0 = nv0, cv1 = nv1;
      if (j != 0 && (h * 2 + d) != cur_hd) {
        cur_hd = h * 2 + d;
#pragma unroll
        for (int e = 0; e < 16; ++e) {
          const float l0 = G(p.hgrn_lb)[(size_t)(d * 2 + 0) * EI + h * 128 + dk0 + e];
          const float l1 = G(p.hgrn_lb)[(size_t)(d * 2 + 1) * EI + h * 128 + dk0 + e];
          const float mx = fmaxf(l0, l1);
          const float e0 = expf(l0 - mx), e1 = expf(l1 - mx);
          const float p0 = e0 / (e0 + e1), p1 = e1 / (e0 + e1);
          lbv[e] = (p0 + p1) - p0;
        }
      }
#pragma unroll
      for (int e = 0; e < 16; ++e) {
        float f = bf2f(e < 8 ? cf0[e & 7] : cf1[e & 7]);
        f = fminf(fmaxf(f, -30.f), 30.f);
        const float ef = fexp(-f), sg = frcp(1.0f + ef);
        const float lb = lbv[e];
        const float gg = (j == 0) ? -__logf(1.0f + ef) : __logf(lb + (1.0f - lb) * sg);
        gbuf[tau * 128 + dk0 + e] = gg;
        kk[e] = (1.0f - lb) * ef * sg;
        float qv = bf2f(e < 8 ? cq0[e & 7] : cq1[e & 7]);
        const float qc = fminf(fmaxf(qv, -30.f), 30.f);
        qq[e] = qv * frcp(1.0f + fexp(-qc));
        vT[(dk0 + e) * 72 + (tau ^ swz)] = (e < 8 ? cv0[e & 7] : cv1[e & 7]);
      }
    }
    if (item + nblk < 8448) {
      const int it2 = item + nblk, d2 = it2 & 1, h2 = (it2 >> 1) & 31, c2 = it2 >> 6;
      const size_t row = (size_t)c2 * 64 + (d2 ? 63 - tau : tau);
      const bf16_t* rp = P + row * 20480 + h2 * 128 + dk0;
      nf0 = *(const us8*)(rp + (1 + d2) * EI); nf1 = *(const us8*)(rp + (1 + d2) * EI + 8);
      nq0 = *(const us8*)(rp + 3 * EI); nq1 = *(const us8*)(rp + 3 * EI + 8);
      nv0 = *(const us8*)(rp); nv1 = *(const us8*)(rp + 8);
    }
    __syncthreads();
    {
      const int dkc = tid & 127, part = tid >> 7;
      float loc[16], run = 0.f;
#pragma unroll
      for (int t = 0; t < 16; ++t) { run += gbuf[(part * 16 + t) * 128 + dkc]; loc[t] = run; }
      tot[part * 128 + dkc] = run;
      __syncthreads();
      float off = 0.f;
      for (int pp = 0; pp < part; ++pp) off += tot[pp * 128 + dkc];
#pragma unroll
      for (int t = 0; t < 16; ++t) gbuf[(part * 16 + t) * 128 + dkc] = loc[t] + off;
    }
    __syncthreads();
    if (tid < 128) {
      const float bm = gbuf[31 * 128 + tid], bl = gbuf[63 * 128 + tid];
      cem[tid] = fexp(bm); celm[tid] = fexp(bl - bm);
      DEC[((size_t)(chunk * 32 + h) * 2 + d) * 128 + tid] = fexp(bl);
    }
    __syncthreads();
    {
      us8 oq[2], ok[2], ob[2];
      const int rn = d ? 63 - tau : tau;
#pragma unroll
      for (int e = 0; e < 16; ++e) {
        const float bc = gbuf[tau * 128 + dk0 + e], bm = gbuf[31 * 128 + dk0 + e];
        const float E1 = fexp(fminf(fmaxf(bc - bm, -80.f), 80.f)), R1 = frcp(E1);
        const float qev = qq[e] * E1, kev = kk[e] * R1;
        oq[e >> 3][e & 7] = f2bf(qev);
        ok[e >> 3][e & 7] = f2bf(kev);
        ob[e >> 3][e & 7] = f2bf(qev * cem[dk0 + e]);
        kbT[(dk0 + e) * 72 + (rn ^ swz)] = f2bf(kev * celm[dk0 + e]);
      }
      *(us8*)(qe + tau * 136 + dk0) = oq[0]; *(us8*)(qe + tau * 136 + dk0 + 8) = oq[1];
      *(us8*)(ke + tau * 136 + dk0) = ok[0]; *(us8*)(ke + tau * 136 + dk0 + 8) = ok[1];
      {
        bf16_t* qbase = QB + (size_t)((d * 132 + chunk) * 32 + h) * 8192;
        const int k8 = dk0 >> 3;
        *(us8*)(qbase + ((tau >> 4) * 4 + (k8 >> 2)) * 512 + ((tau & 15) + 16 * (k8 & 3)) * 8) = ob[0];
        *(us8*)(qbase + ((tau >> 4) * 4 + ((k8 + 1) >> 2)) * 512 + ((tau & 15) + 16 * ((k8 + 1) & 3)) * 8) = ob[1];
      }
    }
    __syncthreads();
    {
      const int mt = wid >> 1;
#pragma unroll
      for (int nn = 0; nn < 2; ++nn) {
        const int nt2 = (wid & 1) * 2 + nn;
        f32x4 a4 = (f32x4){0.f, 0.f, 0.f, 0.f};
#pragma unroll
        for (int ks = 0; ks < 4; ++ks) {
          const bf16x8 a = *(const bf16x8*)(qe + (mt * 16 + fr) * 136 + ks * 32 + fq * 8);
          const bf16x8 b = *(const bf16x8*)(ke + (nt2 * 16 + fr) * 136 + ks * 32 + fq * 8);
          a4 = MFMA16(a, b, a4);
        }
        const int s = nt2 * 16 + fr;
#pragma unroll
        for (int r = 0; r < 4; ++r) {
          const int t = mt * 16 + fq * 4 + r;
          sc[t * 72 + s] = (s <= t) ? f2bf(a4[r]) : (bf16_t)0;
        }
      }
    }
    __syncthreads();
    {
      bf16x8 av[2];
#pragma unroll
      for (int ks = 0; ks < 2; ++ks) av[ks] = *(const bf16x8*)(vT + (wid * 16 + fr) * 72 + ((ks * 32 + fq * 8) ^ ((wid & 7) * 8)));
#pragma unroll
      for (int jt = 0; jt < 4; ++jt) {
        f32x4 a4 = (f32x4){0.f, 0.f, 0.f, 0.f};
#pragma unroll
        for (int ks = 0; ks < 2; ++ks) {
          const bf16x8 b = *(const bf16x8*)(sc + (jt * 16 + fr) * 72 + ks * 32 + fq * 8);
          a4 = MFMA16(av[ks], b, a4);
        }
        unsigned __attribute__((ext_vector_type(2))) o;
        o[0] = cvt_pk_bf16(a4[0], a4[1]); o[1] = cvt_pk_bf16(a4[2], a4[3]);
        *(unsigned __attribute__((ext_vector_type(2)))*)((bf16_t*)(G(p.ws) + OFF_OFB) + (size_t)((d * 132 + chunk) * 32 + h) * 8192 + ((wid * 4 + jt) * 64 + lane) * 4) = o;
      }
#pragma unroll
      for (int i2 = 0; i2 < 2; ++i2) {
        const int piece = tid + 512 * i2, blk_ = piece >> 6, ln_ = piece & 63;
        const int dk = (blk_ >> 1) * 16 + (ln_ & 15), r8i = (blk_ & 1) * 4 + (ln_ >> 4), r8 = r8i * 8;
        const us8 kv = *(const us8*)(kbT + dk * 72 + (r8 ^ (((dk >> 4) & 7) * 8)));
        const int fo = piece * 16;
        *(us8*)(P + ((size_t)chunk * 64 + (fo >> 8)) * 20480 + (1 + d) * EI + h * 128 + ((fo & 255) >> 1)) = kv;
        if (d == 0) {
          const us8 vv = *(const us8*)(vT + dk * 72 + (r8 ^ (((dk >> 4) & 7) * 8)));
          *(us8*)(VT + (size_t)(chunk * 32 + h) * 8192 + (fo >> 1)) = vv;
        }
      }
    }
    __syncthreads();
  }
}

__device__ void hgrn_seq_phase(const Params& p, int j, int bid, int nblk, int tidx) {
  const int tid = tidx, lane = tid & 63, wid = tid >> 6, fr = lane & 15, fq = lane >> 4;
  bf16_t* ST = (bf16_t*)g_smem;
  const bf16_t* P = (const bf16_t*)(G(p.ws) + OFF_P);
  const bf16_t* QB = (const bf16_t*)(G(p.ws) + OFF_QB);
  const bf16_t* VT = (const bf16_t*)(G(p.ws) + OFF_VT);
  const float* DEC = (const float*)(G(p.ws) + OFF_DEC);
  const int it = wid & 1, jt = wid >> 1;
#pragma unroll 1
  for (int item = bid; item < 256; item += nblk) {
    const int vs = (item >> 3) & 3, hd = (item & 7) + 8 * (item >> 5), h = hd >> 1, d = hd & 1;
    bf16_t* O = (bf16_t*)(G(p.ws) + OFF_OFB) + (size_t)d * MROWS * EI;
    __syncthreads();
    for (int i = tid; i < 2 * 32 * 136; i += NTHREADS) ST[i] = 0;
    f32x4 accS[2];
    accS[0] = (f32x4){0.f, 0.f, 0.f, 0.f}; accS[1] = (f32x4){0.f, 0.f, 0.f, 0.f};
    bf16x8 Aqb[4], Akb[2], Avt[2][2]; f32x4 Adc; us4 Aoi;
    bf16x8 Bqb[4], Bkb[2], Bvt[2][2]; f32x4 Bdc; us4 Boi;
    bf16x8 Cqb[4], Ckb[2], Cvt[2][2]; f32x4 Cdc; us4 Coi;
    const int dkr = 16 * wid + fr;
    const int tq = jt * 16 + fr;
#define CHAIN(n_) (d ? ((n_) < 4 ? 3 - (n_) : 135 - (n_)) : (n_))
#define HSEQ_LOAD(c, S_) do { \
      const bf16_t* qp_ = QB + (size_t)((d * 132 + (c)) * 32 + h) * 8192 + jt * 4 * 512 + lane * 8; \
      _Pragma("unroll") for (int ks = 0; ks < 4; ++ks) S_##qb[ks] = *(const bf16x8*)(qp_ + ks * 512); \
      _Pragma("unroll") for (int ks = 0; ks < 2; ++ks) S_##kb[ks] = *(const bf16x8*)(P + ((size_t)(c) * 64 + (wid * 2 + ks) * 4 + fq) * 20480 + (1 + d) * EI + h * 128 + fr * 8); \
      _Pragma("unroll") for (int nn = 0; nn < 2; ++nn) { \
        const bf16_t* vp_ = VT + (size_t)((c) * 32 + h) * 8192 + ((vs * 2 + nn) * 2) * 512 + lane * 8; \
        _Pragma("unroll") for (int ks = 0; ks < 2; ++ks) S_##vt[nn][ks] = *(const bf16x8*)(vp_ + ks * 512); } \
      S_##dc = *(const f32x4*)(DEC + ((size_t)((c) * 32 + h) * 2 + d) * 128 + 16 * wid + fq * 4); \
    } while (0)
#define HSEQ_STEP(n_, C_, L_) do { \
      const int n = (n_); const int chunk = CHAIN(n); const int cur = n & 1; \
      if (n + 2 < 132) { const int nc = CHAIN(n + 2); HSEQ_LOAD(nc, L_); } \
      { f32x4 a4 = (f32x4){0.f, 0.f, 0.f, 0.f}; \
        const bf16_t* stc = ST + cur * 32 * 136; \
        _Pragma("unroll") for (int ks = 0; ks < 4; ++ks) { \
          const bf16x8 a = *(const bf16x8*)(stc + (it * 16 + fr) * 136 + ks * 32 + fq * 8); \
          a4 = MFMA16(a, C_##qb[ks], a4); } \
        us4 o; \
        _Pragma("unroll") for (int r = 0; r < 4; ++r) o[r] = f2bf(a4[r] + bf2f(oic[(n_) - n0][r])); \
        obuf[(n_) - n0] = o; } \
      { bf16_t* stn = ST + (cur ^ 1) * 32 * 136; \
        _Pragma("unroll") for (int nn = 0; nn < 2; ++nn) { \
          _Pragma("unroll") for (int r = 0; r < 4; ++r) accS[nn][r] *= C_##dc[r]; \
          _Pragma("unroll") for (int ks = 0; ks < 2; ++ks) accS[nn] = MFMA16(C_##kb[ks], C_##vt[nn][ks], accS[nn]); \
          us4 o; \
          _Pragma("unroll") for (int r = 0; r < 4; ++r) o[r] = f2bf(accS[nn][r]); \
          *(us4*)(stn + (nn * 16 + fr) * 136 + wid * 16 + fq * 4) = o; } } \
      asm volatile("s_waitcnt lgkmcnt(0)" ::: "memory"); __builtin_amdgcn_s_barrier(); asm volatile("" ::: "memory"); \
    } while (0)
    us4 oin[6];
#pragma unroll
    for (int k = 0; k < 6; ++k) {
      const int ck = CHAIN(k);
      oin[k] = *(const us4*)((const bf16_t*)(G(p.ws) + OFF_OFB) + (size_t)((d * 132 + ck) * 32 + h) * 8192 + (((vs * 2 + it) * 4 + jt) * 64 + lane) * 4);
    }
    { const int c0 = CHAIN(0); HSEQ_LOAD(c0, A); const int c1 = CHAIN(1); HSEQ_LOAD(c1, B); }
    __syncthreads();
#pragma unroll 1
    for (int n0 = 0; n0 < 132; n0 += 6) {
      us4 obuf[6], oic[6];
#pragma unroll
      for (int k = 0; k < 6; ++k) oic[k] = oin[k];
      if (n0 + 6 < 132) {
#pragma unroll
        for (int k = 0; k < 6; ++k) {
          const int ck = CHAIN(n0 + 6 + k);
          oin[k] = *(const us4*)((const bf16_t*)(G(p.ws) + OFF_OFB) + (size_t)((d * 132 + ck) * 32 + h) * 8192 + (((vs * 2 + it) * 4 + jt) * 64 + lane) * 4);
        }
      }
      HSEQ_STEP(n0, A, C);
      HSEQ_STEP(n0 + 1, B, A);
      HSEQ_STEP(n0 + 2, C, B);
      HSEQ_STEP(n0 + 3, A, C);
      HSEQ_STEP(n0 + 4, B, A);
      HSEQ_STEP(n0 + 5, C, B);
#pragma unroll
      for (int k = 0; k < 6; ++k) {
        const int ck = CHAIN(n0 + k);
        *(us4*)((bf16_t*)(G(p.ws) + OFF_OFB) + (size_t)((d * 132 + ck) * 32 + h) * 8192 + (((vs * 2 + it) * 4 + jt) * 64 + lane) * 4) = obuf[k];
      }
    }
#undef HSEQ_STEP
#undef CHAIN
#undef HSEQ_LOAD
  }
}

__device__ void hgrn_finish_phase(const Params& p, int j, int bid, int nblk, int tidx) {
  const int tid = tidx, lane = tid & 63, wid = tid >> 6, fr = lane & 15, fq = lane >> 4;
  const bf16_t* OF = (const bf16_t*)(G(p.ws) + OFF_OFB);
  const bf16_t* P = (const bf16_t*)(G(p.ws) + OFF_P);
  bf16_t* OH = (bf16_t*)(G(p.ws) + OFF_OH);
  const float* onorm = G(p.hgrn_norm) + (size_t)j * EI;
  float* tb = (float*)g_smem + wid * 2048;
#pragma unroll 1
  for (int wi = bid * 8 + wid; wi < 132 * 32 * 4; wi += nblk * 8) {
    const int jt = wi & 3, h = (wi >> 2) & 31, chunk = wi >> 7;
    const bf16_t* fb = OF + (size_t)((0 * 132 + chunk) * 32 + h) * 8192 + (jt * 64 + lane) * 4;
    const bf16_t* bb = OF + (size_t)((1 * 132 + chunk) * 32 + h) * 8192 + ((3 - jt) * 64 + (15 - fr) + 16 * fq) * 4;
    float o[8][4], ss = 0.f;
#pragma unroll
    for (int pp = 0; pp < 8; ++pp) {
      const us4 a = *(const us4*)(fb + pp * 1024), b = *(const us4*)(bb + pp * 1024);
#pragma unroll
      for (int e = 0; e < 4; ++e) { o[pp][e] = bf2f(a[e]) + bf2f(b[e]); ss += o[pp][e] * o[pp][e]; }
    }
    ss += __shfl_xor(ss, 16); ss += __shfl_xor(ss, 32);
    const float inv = rsqrtf(ss * (1.0f / 128.0f) + 1e-6f);
#pragma unroll
    for (int pp = 0; pp < 8; ++pp) {
      f32x4 t;
#pragma unroll
      for (int e = 0; e < 4; ++e) t[e] = o[pp][e] * inv;
      *(f32x4*)(tb + fr * 128 + (((pp * 4 + fq) ^ (fr & 7)) << 2)) = t;
    }
    const int c8 = (lane & 15) * 8, ch = h * 128 + c8;
    const f32x4 n0 = *(const f32x4*)(onorm + ch), n1 = *(const f32x4*)(onorm + ch + 4);
#pragma unroll
    for (int ps = 0; ps < 4; ++ps) {
      const int rr = ps * 4 + (lane >> 4);
      const f32x4 t0 = *(const f32x4*)(tb + rr * 128 + ((((lane & 15) * 2) ^ (rr & 7)) << 2));
      const f32x4 t1 = *(const f32x4*)(tb + rr * 128 + ((((lane & 15) * 2 + 1) ^ (rr & 7)) << 2));
      const size_t row = (size_t)chunk * 64 + jt * 16 + rr;
      const us8 z = *(const us8*)(P + row * 20480 + 4 * EI + ch);
      u32x4 out;
#pragma unroll
      for (int e = 0; e < 4; ++e) {
        const float v0 = (e < 2 ? t0[2 * e] * n0[2 * e] : t1[2 * e - 4] * n1[2 * e - 4]);
        const float v1 = (e < 2 ? t0[2 * e + 1] * n0[2 * e + 1] : t1[2 * e - 3] * n1[2 * e - 3]);
        const float z0 = bf2f(z[2 * e]), z1 = bf2f(z[2 * e + 1]);
        out[e] = cvt_pk_bf16(v0 * (z0 * sigmoidf_(z0)), v1 * (z1 * sigmoidf_(z1)));
      }
      *(u32x4*)(OH + row * EI + ch) = out;
    }
  }
}

#define NPHASES 24
__device__ __forceinline__ void decode_phase(int ph, int& layer, int& kind) {
  if (ph == 0) { layer = 0; kind = 0; return; }
  if (ph == 23) { layer = 4; kind = 1; return; }
  int q = ph - 1;
  if (q >= 11) { q -= 11; layer = 2; } else layer = 0;
  if (q < 5) { kind = (q == 0) ? 1 : (q == 1) ? 2 : (q == 2) ? 3 : (q == 3) ? 4 : 5; }
  else { q -= 5; layer += 1; kind = (q == 0) ? 1 : (q == 1) ? 2 : (q == 2) ? 6 : (q == 3) ? 7 : (q == 4) ? 8 : 5; }
}
__device__ void run_phase(const Params& p, int ph, int bid, int nblk, int tidx) {
  int i, kind; decode_phase(ph, i, kind);
#ifdef ONLYK
  if (!((ONLYK >> kind) & 1)) return;
#endif
  const int j = (i >> 1) & 1;
  const bool is_s5 = (i & 1) == 0;
  if (kind == 0) { adaln_phase(p, bid, nblk, tidx); __syncthreads(); convert_phase(p, bid, nblk, tidx); return; }
  if (kind == 1) { norm_phase(p, i, bid, nblk, tidx); return; }
  if (kind == 3) { s5_phase(p, j, bid, nblk, tidx); return; }
  if (kind == 6) { hgrn_pre_phase(p, j, bid, nblk, tidx); return; }
  if (kind == 7) { hgrn_seq_phase(p, j, bid, nblk, tidx); return; }
  if (kind == 8) { hgrn_finish_phase(p, j, bid, nblk, tidx); return; }
  const int s = (kind == 2) ? 1 : (kind == 4) ? 3 : 4;
  const bf16_t* A; const bf16_t* Bt; int N, K;
  if (s == 1) {
    A = (const bf16_t*)(G(p.ws) + OFF_HX); K = 2048;
    if (is_s5) { Bt = (const bf16_t*)(G(p.ws) + OFF_WS5IN + j * SZ_WS5IN); N = 8192; }
    else { Bt = (const bf16_t*)(G(p.ws) + OFF_WHIN + j * SZ_WHIN); N = 20480; }
  } else if (s == 3) {
    A = (const bf16_t*)(G(p.ws) + OFF_YG); Bt = (const bf16_t*)(G(p.ws) + OFF_WGLU + j * SZ_WGLU); N = 4096; K = 4096;
  } else {
    A = is_s5 ? (const bf16_t*)(G(p.ws) + OFF_V) : (const bf16_t*)(G(p.ws) + OFF_OH);
    Bt = is_s5 ? (const bf16_t*)(G(p.ws) + OFF_WS5OUT + j * SZ_WOUT) : (const bf16_t*)(G(p.ws) + OFF_WHOUT + j * SZ_WOUT);
    N = 2048; K = 4096;
  }
#ifndef RPTB
#define RPTB 1
#endif
#ifndef RPTS
#define RPTS 1
#endif
  const bool ctx_big = (s == 1) && !is_s5;
  gemm_phase(ctx_big ? A : A + (size_t)CTXL * K, Bt, ctx_big ? MROWS : SEQL, N, K, p, s, is_s5 ? 1 : 0, j, bid, nblk, tidx);
  if (!ctx_big && !(s == 4 && i == 3)) gemm_small_phase(A, Bt, N, K, p, s, is_s5 ? 1 : 0, j, bid, nblk, tidx);
}

#define XB_TMO      128
#define XB_XCNT(j)  (256  + 64 * (j))
#define XB_XSUB(j)  (1280 + 64 * (j))
#define XB_XGEN(j)  (2304 + 64 * (j))
#define XB_TOP      3328
#define XB_TOPGEN   3392
#define XCD_BAR_WORDS 3456
#define XB_SPIN_CAP (1u << 18)
__device__ __forceinline__ unsigned xb_ld(unsigned* p) { return __hip_atomic_load(p, __ATOMIC_RELAXED, __HIP_MEMORY_SCOPE_AGENT); }
__device__ __forceinline__ unsigned xb_add(unsigned* p, unsigned v) { return __hip_atomic_fetch_add(p, v, __ATOMIC_RELAXED, __HIP_MEMORY_SCOPE_AGENT); }
__device__ __forceinline__ unsigned xb_xcc_id() { return (unsigned)__builtin_amdgcn_s_getreg((3 << 11) | 20) & 0xFu; }
#define XB_SPIN(cond, bar) do { unsigned _sp = 0; while (cond) { __builtin_amdgcn_s_sleep(1); \
    if ((++_sp & 255u) == 0u) { if (xb_ld(&(bar)[XB_TMO])) break; if (_sp > XB_SPIN_CAP) { atomicAdd(&(bar)[XB_TMO], 1u); break; } } } } while (0)
__device__ __forceinline__ void xcd_barrier_complete(unsigned* bar, unsigned x, unsigned G, unsigned& nloc, unsigned& nx) {
  unsigned sum, cnt, mine, sp = 0u;
  for (;;) {
    sum = 0u; cnt = 0u; mine = 0u;
#pragma unroll
    for (unsigned j = 0; j < 16; ++j) { const unsigned c = xb_ld(&bar[XB_XCNT(j)]); sum += c; cnt += (c > 0u) ? 1u : 0u; mine = (j == x) ? c : mine; }
    if (sum == G) break;
    __builtin_amdgcn_s_sleep(1);
    if ((++sp & 255u) == 0u) { if (xb_ld(&bar[XB_TMO])) break; if (sp > XB_SPIN_CAP) { atomicAdd(&bar[XB_TMO], 1u); break; } }
  }
  nloc = mine > 0u ? mine : 1u; nx = cnt > 0u ? cnt : 1u;
}
__device__ __forceinline__ void xcd_barrier(unsigned* bar, volatile LAS unsigned* st, bool leader_thread, unsigned G) {
  asm volatile("s_waitcnt vmcnt(0)" ::: "memory");
  __syncthreads();
  if (leader_thread) {
    const unsigned x = xb_xcc_id();
    __builtin_amdgcn_s_waitcnt(0);
    unsigned nloc = st[0], nx = st[1];
    if (nloc == 0u) { xcd_barrier_complete(bar, x, G, nloc, nx); st[0] = nloc; st[1] = nx; }
    const unsigned old = xb_add(&bar[XB_XSUB(x)], 1u);
    const unsigned gen = old / nloc;
    if (old + 1u == (gen + 1u) * nloc) {
      __builtin_amdgcn_fence(__ATOMIC_RELEASE, "agent");
      asm volatile("s_waitcnt vmcnt(0)" ::: "memory");
      const unsigned og = xb_add(&bar[XB_TOP], 1u);
      const unsigned tg = og / nx;
      if (og + 1u == (tg + 1u) * nx) xb_add(&bar[XB_TOPGEN], 1u);
      else XB_SPIN(xb_ld(&bar[XB_TOPGEN]) == tg, bar);
      __builtin_amdgcn_fence(__ATOMIC_ACQUIRE, "agent");
      xb_add(&bar[XB_XGEN(x)], 1u);
      asm volatile("s_waitcnt vmcnt(0)" ::: "memory");
    } else {
      XB_SPIN(xb_ld(&bar[XB_XGEN(x)]) == gen, bar);
      __builtin_amdgcn_fence(__ATOMIC_ACQUIRE, "agent");
      asm volatile("s_waitcnt vmcnt(0)" ::: "memory");
    }
  }
  __syncthreads();
}

__global__ void __launch_bounds__(NTHREADS) mega(Params p, int ph_lo, int ph_hi) {
  cg::grid_group grid = cg::this_grid();
  const int wave_id = __builtin_amdgcn_readfirstlane((int)(threadIdx.x >> 6));
  {
    volatile LAS unsigned* st0 = (volatile LAS unsigned*)((LAS unsigned char*)g_smem + 149760);
    if (threadIdx.x < 2) st0[threadIdx.x] = 0u;
    if (blockIdx.x == 0) { unsigned* bw = (unsigned*)(G(p.ws) + OFF_BAR); for (int i = threadIdx.x; i < XCD_BAR_WORDS; i += NTHREADS) bw[i] = 0u; }
    __syncthreads();
  }
#pragma unroll 1
  for (int ph = ph_lo; ph < ph_hi; ++ph) {
    const Params* pp = (const Params*)__builtin_amdgcn_kernarg_segment_ptr();
    asm volatile("" : "+s"(pp));
    int wv = wave_id; asm volatile("" : "+s"(wv));
    int tidx = wv * 64 + (int)__builtin_amdgcn_mbcnt_hi(~0u, __builtin_amdgcn_mbcnt_lo(~0u, 0u));
    asm volatile("" : "+v"(tidx));
    run_phase(*pp, ph, blockIdx.x, gridDim.x, tidx);
    if (ph + 1 < ph_hi) {
      if (ph == ph_lo) {
        grid.sync();
        if (threadIdx.x == 0) (void)xb_add((unsigned*)(G(pp->ws) + OFF_BAR) + XB_XCNT(xb_xcc_id()), 1u);
      }
      else xcd_barrier((unsigned*)(G(pp->ws) + OFF_BAR), (volatile LAS unsigned*)((LAS unsigned char*)g_smem + 149760), tidx == 0, gridDim.x);
    }
  }
}

extern "C" void kernel_launch(void* const* d_in, const int* in_sizes, int n_in, void* d_out, int out_size, void* d_ws, size_t ws_size,
                              hipStream_t stream) {
  static int grid_blocks = 0;
  if (!grid_blocks) {
    hipFuncSetAttribute((const void*)mega, hipFuncAttributeMaxDynamicSharedMemorySize, LDS_BYTES);
    int dev = 0, cus = 0, per_cu = 0;
    hipGetDevice(&dev);
    hipDeviceGetAttribute(&cus, hipDeviceAttributeMultiprocessorCount, dev);
    hipOccupancyMaxActiveBlocksPerMultiprocessor(&per_cu, mega, NTHREADS, LDS_BYTES);
    if (per_cu < 1) per_cu = 1;
    grid_blocks = cus * per_cu;
    if (grid_blocks > 256) grid_blocks = 256;
  }
  Params p{};
  const float* const* in = (const float* const*)d_in;
  p.x = (const float GAS*)in[0]; p.c = (const float GAS*)in[1]; p.ctx = (const float GAS*)in[2]; p.cctx = (const float GAS*)in[3]; p.ada_w = (const float GAS*)in[4]; p.ada_b = (const float GAS*)in[5]; p.norm_pre = (const float GAS*)in[6]; p.norm_post = (const float GAS*)in[7];
  p.s5_w_in = (const float GAS*)in[8]; p.s5_lam_re = (const float GAS*)in[9]; p.s5_lam_im = (const float GAS*)in[10]; p.s5_log_dt = (const float GAS*)in[11]; p.s5_b_re = (const float GAS*)in[12]; p.s5_b_im = (const float GAS*)in[13];
  p.s5_c_re = (const float GAS*)in[14]; p.s5_c_im = (const float GAS*)in[15]; p.s5_d = (const float GAS*)in[16]; p.s5_w_glu = (const float GAS*)in[17]; p.s5_b_glu = (const float GAS*)in[18]; p.s5_w_out = (const float GAS*)in[19];
  p.hgrn_w_in = (const float GAS*)in[20]; p.hgrn_lb = (const float GAS*)in[21]; p.hgrn_norm = (const float GAS*)in[22]; p.hgrn_w_out = (const float GAS*)in[23];
  p.out = (float GAS*)d_out; p.ws = (unsigned char GAS*)d_ws;
#if COOP
  int lo = 0, hi = NPHASES;
  void* args[] = {&p, &lo, &hi};
  hipError_t e = hipLaunchCooperativeKernel((void*)mega, dim3(grid_blocks), dim3(NTHREADS), args, LDS_BYTES, stream);
  if (e != hipSuccess) fprintf(stderr, "cooperative launch failed: %s (grid %d)\n", hipGetErrorString(e), grid_blocks);
#else
  for (int ph = 0; ph < NPHASES; ++ph) {
    hipLaunchKernelGGL(mega, dim3(grid_blocks), dim3(NTHREADS), LDS_BYTES, stream, p, ph, ph + 1);
  }
#endif
}
```

```cpp
#include <hip/hip_runtime.h>
#include <hip/hip_cooperative_groups.h>
#include <cstdio>
namespace cg = cooperative_groups;

#ifndef COOP
#define COOP 1
#endif

typedef unsigned short bf16_t;
typedef short bf16x8 __attribute__((ext_vector_type(8)));
typedef float f32x4 __attribute__((ext_vector_type(4)));
typedef unsigned short us4 __attribute__((ext_vector_type(4)));
typedef unsigned short us8 __attribute__((ext_vector_type(8)));
typedef unsigned u32x4 __attribute__((ext_vector_type(4)));

#define DM 2048
#define SEQL 8192
#define CTXL 256
#define MROWS 8448
#define EI 4096
#define NTHREADS 512
#define LDS_BYTES 149776

extern __shared__ __attribute__((aligned(16))) unsigned char g_smem[];

typedef __bf16 bf16v2_t __attribute__((ext_vector_type(2)));
typedef float f32x2_t __attribute__((ext_vector_type(2)));
__device__ __forceinline__ unsigned cvt_pk_bf16(float lo, float hi) { const f32x2_t v = {lo, hi}; return __builtin_bit_cast(unsigned, __builtin_convertvector(v, bf16v2_t)); }
__device__ __forceinline__ bf16_t f2bf(float f) { return (bf16_t)(cvt_pk_bf16(f, f) & 0xffffu); }
__device__ __forceinline__ float bf2f(bf16_t h) { return __uint_as_float(((unsigned)h) << 16); }
__device__ __forceinline__ float sigmoidf_(float x) { return 1.0f / (1.0f + __expf(-x)); }

constexpr size_t SZ_WS5IN = (size_t)8192 * 2048 * 2;
constexpr size_t SZ_WGLU = (size_t)4096 * 4096 * 2;
constexpr size_t SZ_WOUT = (size_t)2048 * 4096 * 2;
constexpr size_t SZ_WHIN = (size_t)20480 * 2048 * 2;
constexpr size_t OFF_WS5IN = 0;
constexpr size_t OFF_WGLU = OFF_WS5IN + 2 * SZ_WS5IN;
constexpr size_t OFF_WS5OUT = OFF_WGLU + 2 * SZ_WGLU;
constexpr size_t OFF_WHIN = OFF_WS5OUT + 2 * SZ_WOUT;
constexpr size_t OFF_WHOUT = OFF_WHIN + 2 * SZ_WHIN;
constexpr size_t OFF_MOD = OFF_WHOUT + 2 * SZ_WOUT;
constexpr size_t OFF_XCUR = OFF_MOD + 4 * 2 * 6144 * 4;
constexpr size_t OFF_HX = OFF_XCUR + (size_t)MROWS * DM * 4;
constexpr size_t OFF_OX = OFF_HX + (size_t)MROWS * DM * 2;
constexpr size_t OFF_P = OFF_OX + (size_t)MROWS * DM * 4;
constexpr size_t OFF_R = OFF_P + (size_t)MROWS * 20480 * 2;
constexpr size_t OFF_YG = OFF_R;
constexpr size_t OFF_V = OFF_YG + (size_t)MROWS * EI * 2;
constexpr size_t OFF_S5SCR = OFF_V + (size_t)MROWS * EI * 2;
constexpr size_t S5_S = 0;
constexpr size_t S5_H = S5_S + 270336;
constexpr size_t S5_PER = S5_H + 135168;
constexpr size_t OFF_OFB = OFF_R;
constexpr size_t OFF_QB = OFF_OFB + (size_t)2 * MROWS * EI * 2;
constexpr size_t OFF_VT = OFF_QB + (size_t)2 * MROWS * EI * 2;
constexpr size_t OFF_DEC = OFF_VT + (size_t)MROWS * EI * 2;
constexpr size_t OFF_OH = OFF_DEC + (size_t)132 * 32 * 2 * 128 * 4;
constexpr size_t OFF_BAR = OFF_OH + (size_t)MROWS * EI * 2;
constexpr size_t WS_TOTAL = OFF_BAR + 16384;
static_assert(WS_TOTAL <= (size_t)4 * 2 * 2048 * 20480 * 4, "workspace overflow");

#define GAS __attribute__((address_space(1)))
struct Params {
  const float GAS *x, *c, *ctx, *cctx, *ada_w, *ada_b, *norm_pre, *norm_post;
  const float GAS *s5_w_in, *s5_lam_re, *s5_lam_im, *s5_log_dt, *s5_b_re, *s5_b_im, *s5_c_re, *s5_c_im, *s5_d, *s5_w_glu, *s5_b_glu, *s5_w_out;
  const float GAS *hgrn_w_in, *hgrn_lb, *hgrn_norm, *hgrn_w_out;
  float GAS* out;
  unsigned char GAS* ws;
};

template <class T> __device__ __forceinline__ T* G(GAS T* q) { return (T*)q; }

__device__ void convert_phase(const Params& p, int bid, int nblk, int tidx) {
  float* tile = (float*)g_smem;
  const int tid = tidx;
  const int total = 45056;
  for (int T = bid; T < total; T += nblk) {
    int j = T / 22528, r = T % 22528;
    const float* src; bf16_t* dst; int K, N;
    if (r < 4096) { src = G(p.s5_w_in) + (size_t)j * 2048 * 8192; dst = (bf16_t*)(G(p.ws) + OFF_WS5IN + j * SZ_WS5IN); K = 2048; N = 8192; }
    else if (r < 8192) { r -= 4096; src = G(p.s5_w_glu) + (size_t)j * 4096 * 4096; dst = (bf16_t*)(G(p.ws) + OFF_WGLU + j * SZ_WGLU); K = 4096; N = 4096; }
    else if (r < 10240) { r -= 8192; src = G(p.s5_w_out) + (size_t)j * 4096 * 2048; dst = (bf16_t*)(G(p.ws) + OFF_WS5OUT + j * SZ_WOUT); K = 4096; N = 2048; }
    else if (r < 20480) { r -= 10240; src = G(p.hgrn_w_in) + (size_t)j * 2048 * 20480; dst = (bf16_t*)(G(p.ws) + OFF_WHIN + j * SZ_WHIN); K = 2048; N = 20480; }
    else { r -= 20480; src = G(p.hgrn_w_out) + (size_t)j * 4096 * 2048; dst = (bf16_t*)(G(p.ws) + OFF_WHOUT + j * SZ_WOUT); K = 4096; N = 2048; }
    const int nNt = N >> 6;
    const int k0 = (r / nNt) << 6, n0 = (r % nNt) << 6;
    {
      const int kk = tid >> 4, n4 = tid & 15;
#pragma unroll
      for (int ps = 0; ps < 2; ++ps) {
        const int k = ps * 32 + kk;
        f32x4 v = __builtin_nontemporal_load((const f32x4*)(src + (size_t)(k0 + k) * N + n0 + n4 * 4));
        tile[k * 65 + n4 * 4 + 0] = v[0]; tile[k * 65 + n4 * 4 + 1] = v[1];
        tile[k * 65 + n4 * 4 + 2] = v[2]; tile[k * 65 + n4 * 4 + 3] = v[3];
      }
    }
    __syncthreads();
    {
      const int n = tid >> 3, k8 = tid & 7;
      us8 o;
#pragma unroll
      for (int i = 0; i < 8; ++i) o[i] = f2bf(tile[(k8 * 8 + i) * 65 + n]);
      *(us8*)(dst + (size_t)(n0 + n) * K + k0 + k8 * 8) = o;
    }
    __syncthreads();
  }
}

__device__ void adaln_phase(const Params& p, int bid, int nblk, int tidx) {
  float* sc = (float*)g_smem;
  float* red = sc + 4096;
  float* mod = (float*)(G(p.ws) + OFF_MOD);
  const int tid = tidx;
  bool inited = false;
  for (int it = bid; it < 384; it += nblk) {
    if (!inited) {
      for (int k = tid; k < 2048; k += NTHREADS) {
        float a = G(p.c)[k], b = G(p.cctx)[k];
        sc[k] = a * sigmoidf_(a); sc[2048 + k] = b * sigmoidf_(b);
      }
      inited = true;
      __syncthreads();
    }
    const int i = it / 96, col0 = (it % 96) * 64;
    const int cg4 = tid & 15, ks = tid >> 4;
    float acc[8];
#pragma unroll
    for (int e = 0; e < 8; ++e) acc[e] = 0.f;
    const float* wp = G(p.ada_w) + (size_t)i * 2048 * 6144 + col0 + cg4 * 4;
#pragma unroll 4
    for (int kk = 0; kk < 64; ++kk) {
      const int k = kk * 32 + ks;
      f32x4 w = __builtin_nontemporal_load((const f32x4*)(wp + (size_t)k * 6144));
      const float s0 = sc[k], s1 = sc[2048 + k];
#pragma unroll
      for (int e = 0; e < 4; ++e) { acc[e] += w[e] * s0; acc[4 + e] += w[e] * s1; }
    }
#pragma unroll
    for (int e = 0; e < 8; ++e) red[(ks * 16 + cg4) * 8 + e] = acc[e];
    __syncthreads();
    if (tid < 128) {
      const int c4 = tid >> 3, v = tid & 7;
      float s = 0.f;
      for (int q = 0; q < 32; ++q) s += red[(q * 16 + c4) * 8 + v];
      const int which = v >> 2, col = col0 + c4 * 4 + (v & 3);
      mod[(i * 2 + which) * 6144 + col] = s + G(p.ada_b)[i * 6144 + col];
    }
    __syncthreads();
  }
}

__device__ __forceinline__ float wave_sum(float v) {
#pragma unroll
  for (int o = 32; o > 0; o >>= 1) v += __shfl_xor(v, o);
  return v;
}
__device__ __forceinline__ int perm_row(int layer, int l) { return (layer >= 2) ? ((l & 63) * 128 + (l >> 6)) : l; }

__device__ void norm_phase(const Params& p, int i, int bid, int nblk, int tidx) {
  const int tid = tidx, lane = tid & 63, wid = tid >> 6;
  const float* mod = (const float*)(G(p.ws) + OFF_MOD);
  float* xcur = (float*)(G(p.ws) + OFF_XCUR);
  const bf16_t* ox = (const bf16_t*)(G(p.ws) + OFF_OX);
  bf16_t* hx = (bf16_t*)(G(p.ws) + OFF_HX);
  for (int r = bid * 8 + wid; r < MROWS; r += nblk * 8) {
    const bool isctx = r < CTXL;
    const int l = r - CTXL;
    if (i == 4 && isctx) continue;
    const int which = isctx ? 1 : 0;
    const float* xs = (i <= 1) ? (isctx ? G(p.ctx) + (size_t)r * DM : G(p.x) + (size_t)l * DM) : xcur + (size_t)r * DM;
    f32x4 xv[8];
#pragma unroll
    for (int q = 0; q < 8; ++q) xv[q] = (i <= 1) ? __builtin_nontemporal_load((const f32x4*)(xs + (q * 64 + lane) * 4)) : *(const f32x4*)(xs + (q * 64 + lane) * 4);
    if (i > 0) {
      const int orow = isctx ? r : CTXL + perm_row(i - 1, l);
      const bf16_t* os = ox + (size_t)orow * DM;
      f32x4 ov[8];
      float ss = 0.f;
#pragma unroll
      for (int q = 0; q < 8; ++q) {
        { const us4 t_ = *(const us4*)(os + (q * 64 + lane) * 4); ov[q] = (f32x4){bf2f(t_[0]), bf2f(t_[1]), bf2f(t_[2]), bf2f(t_[3])}; }
        ss += ov[q][0] * ov[q][0] + ov[q][1] * ov[q][1] + ov[q][2] * ov[q][2] + ov[q][3] * ov[q][3];
      }
      ss = wave_sum(ss);
      const float inv = rsqrtf(ss * (1.0f / DM) + 1e-6f);
      const float* gate = mod + ((i - 1) * 2 + which) * 6144 + 4096;
      const float* np = G(p.norm_post) + (i - 1) * DM;
#pragma unroll
      for (int q = 0; q < 8; ++q) {
        const int col = (q * 64 + lane) * 4;
        f32x4 gv = *(const f32x4*)(gate + col), nv = *(const f32x4*)(np + col);
#pragma unroll
        for (int e = 0; e < 4; ++e) xv[q][e] += gv[e] * (ov[q][e] * inv * nv[e]);
      }
      float* xd = (i == 4) ? G(p.out) + (size_t)l * DM : xcur + (size_t)r * DM;
#pragma unroll
      for (int q = 0; q < 8; ++q) *(f32x4*)(xd + (q * 64 + lane) * 4) = xv[q];
    }
    if (i < 4) {
      float ss = 0.f;
#pragma unroll
      for (int q = 0; q < 8; ++q) ss += xv[q][0] * xv[q][0] + xv[q][1] * xv[q][1] + xv[q][2] * xv[q][2] + xv[q][3] * xv[q][3];
      ss = wave_sum(ss);
      const float inv = rsqrtf(ss * (1.0f / DM) + 1e-6f);
      const float* shift = mod + (i * 2 + which) * 6144;
      const float* scale = shift + 2048;
      const float* np = G(p.norm_pre) + i * DM;
      const int hrow = isctx ? r : CTXL + perm_row(i, l);
      bf16_t* hd = hx + (size_t)hrow * DM;
#pragma unroll
      for (int q = 0; q < 8; ++q) {
        const int col = (q * 64 + lane) * 4;
        f32x4 sh = *(const f32x4*)(shift + col), scv = *(const f32x4*)(scale + col), nv = *(const f32x4*)(np + col);
        us4 o;
#pragma unroll
        for (int e = 0; e < 4; ++e) o[e] = f2bf((xv[q][e] * inv) * nv[e] * (1.0f + scv[e]) + sh[e]);
        *(us4*)(hd + col) = o;
      }
    }
  }
}

constexpr int BM = 256, BK = 64, HALF = 128, NXCD = 8, WGM = 4, HT = HALF * BK;

__device__ __forceinline__ int lds_byte(int r, int c) {
  int st = (r >> 4) * 2 + (c >> 5), rr = r & 15, cc = c & 31, ob = rr * 64 + cc * 2;
  return st * 1024 + (ob ^ (((ob >> 9) & 1) << 5));
}
__device__ __forceinline__ void stage_rc(int b, int& R, int& C) {
  int st = b / 1024, sb = b % 1024, swz = sb ^ (((sb >> 9) & 1) << 5);
  R = (st >> 1) * 16 + swz / 64; C = (st & 1) * 32 + (swz % 64) / 2;
}

struct EpiAny {
  int mode; void* O; int ld; const bf16_t* yg; const bf16_t* z; int ldz; const float* bias;
  __device__ __forceinline__ void operator()(const f32x4 (&acc)[2][2][4][2], int brow, int bcol, int wr, int wc, int fr, int fq) const {
    if (mode == 0) {
      bf16_t* Ob = (bf16_t*)O;
      const int lane_ = fr + 16 * fq, wid_ = wr * 4 + wc;
      unsigned char __attribute__((address_space(3)))* tb = (unsigned char __attribute__((address_space(3)))*)g_smem + 131072 + wid_ * 2048;
#pragma unroll
      for (int ai = 0; ai < 2; ++ai)
#pragma unroll
        for (int bj = 0; bj < 2; ++bj)
#pragma unroll
          for (int hh = 0; hh < 2; ++hh) {
#pragma unroll
            for (int mm = 0; mm < 2; ++mm)
#pragma unroll
              for (int n = 0; n < 2; ++n) {
                const f32x4 v = acc[ai][bj][hh * 2 + mm][n];
                unsigned __attribute__((ext_vector_type(2))) o2;
                o2[0] = cvt_pk_bf16(v[0], v[1]); o2[1] = cvt_pk_bf16(v[2], v[3]);
                *(unsigned __attribute__((ext_vector_type(2))) __attribute__((address_space(3)))*)(tb + (mm * 16 + fr) * 64 + (((n * 16 + fq * 4) * 2) ^ (((fr >> 1) & 3) << 4))) = o2;
              }
#pragma unroll
            for (int ps = 0; ps < 2; ++ps) {
              const int rr = ps * 16 + (lane_ >> 2);
              const us8 o = *(const us8 __attribute__((address_space(3)))*)(tb + rr * 64 + (((lane_ & 3) * 16) ^ (((rr >> 1) & 3) << 4)));
              const int row = brow + ai * HALF + wr * 64 + hh * 32 + rr;
              const int col = bcol + bj * HALF + wc * 32 + (lane_ & 3) * 8;
              *(us8*)(Ob + (size_t)row * ld + col) = o;
            }
          }
    } else {
      const int lane_ = fr + 16 * fq, wid_ = wr * 4 + wc;
      unsigned char __attribute__((address_space(3)))* tb = (unsigned char __attribute__((address_space(3)))*)g_smem + 131072 + wid_ * 2048;
      const int rr = lane_ >> 2, g0 = (lane_ & 3) * 2;
#pragma unroll
      for (int ai = 0; ai < 2; ++ai)
#pragma unroll
        for (int bj = 0; bj < 2; ++bj)
#pragma unroll
          for (int m = 0; m < 4; ++m) {
#pragma unroll
            for (int n = 0; n < 2; ++n)
              *(f32x4 __attribute__((address_space(3)))*)(tb + fr * 128 + (((n * 4 + fq) ^ (fr & 7)) << 4)) = acc[ai][bj][m][n];
            const f32x4 s0 = *(const f32x4 __attribute__((address_space(3)))*)(tb + rr * 128 + (((g0) ^ (rr & 7)) << 4));
            const f32x4 s1 = *(const f32x4 __attribute__((address_space(3)))*)(tb + rr * 128 + (((g0 + 1) ^ (rr & 7)) << 4));
            const int row = brow + ai * HALF + wr * 64 + m * 16 + rr;
            const int col = bcol + bj * HALF + wc * 32 + (lane_ & 3) * 8;
            if (mode == 1) {
              float* op = (float*)O + (size_t)row * ld + col;
              *(f32x4*)op = s0; *(f32x4*)(op + 4) = s1;
            } else {
              const us8 yv = *(const us8*)(yg + (size_t)row * EI + col);
              const us8 zv = *(const us8*)(z + (size_t)row * ldz + col);
              const f32x4 b0 = *(const f32x4*)(bias + col), b1 = *(const f32x4*)(bias + col + 4);
              u32x4 o;
#pragma unroll
              for (int e = 0; e < 4; ++e) {
                const float a0 = (e < 2 ? s0[2 * e] + b0[2 * e] : s1[2 * e - 4] + b1[2 * e - 4]);
                const float a1 = (e < 2 ? s0[2 * e + 1] + b0[2 * e + 1] : s1[2 * e - 3] + b1[2 * e - 3]);
                const float y0 = bf2f(yv[2 * e]), y1 = bf2f(yv[2 * e + 1]), z0 = bf2f(zv[2 * e]), z1 = bf2f(zv[2 * e + 1]);
                o[e] = cvt_pk_bf16(y0 * sigmoidf_(a0) * (z0 * sigmoidf_(z0)), y1 * sigmoidf_(a1) * (z1 * sigmoidf_(z1)));
              }
              *(u32x4*)((bf16_t*)O + (size_t)row * EI + col) = o;
            }
          }
    }
  }
};

#define LAS __attribute__((address_space(3)))
struct Unit { int pm, pn; };
struct TileOrder {
  int nM, nN, nwg, G, c;
  __device__ __forceinline__ bool next(int i, Unit& u) const {
    const long L = (long)i * G + c; if (L >= nwg) return false;
    int wgid = (int)L; { const int q = nwg / NXCD, r = nwg % NXCD, xcd = wgid % NXCD, off = wgid / NXCD; wgid = (xcd < r ? xcd * (q + 1) : r * (q + 1) + (xcd - r) * q) + off; }
    const int nig = WGM * nN, gid = wgid / nig, fm = gid * WGM, gsz = (nM - fm) < WGM ? (nM - fm) : WGM;
    u.pm = fm + ((wgid % nig) % gsz); u.pn = (wgid % nig) / gsz; return true;
  }
};
constexpr int HTB = HALF * BK * 2;

__device__ __forceinline__ EpiAny make_epi(const Params& p, int s, int is_s5, int j) {
  EpiAny e{};
  bf16_t* P = (bf16_t*)(G(p.ws) + OFF_P);
  if (s == 1) { e.mode = 0; e.O = P; e.ld = is_s5 ? 8192 : 20480; }
  else if (s == 3) { e.mode = 2; e.O = G(p.ws) + OFF_V; e.ld = EI; e.yg = (const bf16_t*)(G(p.ws) + OFF_YG); e.z = P + 4096; e.ldz = 8192; e.bias = G(p.s5_b_glu) + (size_t)j * EI; }
  else { e.mode = 0; e.O = G(p.ws) + OFF_OX; e.ld = DM; }
  return e;
}
__device__ __forceinline__ void gemm_phase(const bf16_t* __restrict__ A, const bf16_t* __restrict__ Bt, int M, int N, int K, const Params& p, int es, int eis5, int ej, int bid, int nblk, int tidx) {
  LAS unsigned char* lds = (LAS unsigned char*)g_smem;
  TileOrder S; S.nM = M / BM; S.nN = N / BM; S.nwg = S.nM * S.nN; S.G = nblk; S.c = bid;
  const int tid = tidx, wid = __builtin_amdgcn_readfirstlane(tid >> 6), lane = tid & 63, wr = wid >> 2, wc = wid & 3, fr = lane & 15, fq = lane >> 4;
  const int nt = K / BK;
  unsigned voffA[2];
#pragma unroll
  for (int i = 0; i < 2; ++i) { int R, C; stage_rc(tid * 16 + i * 8192, R, C); voffA[i] = (unsigned)(R * K + C) * 2u; }
  const size_t kstep = (size_t)(BK * 2);
  const size_t hstep = (size_t)HALF * K * 2;
  const size_t tstep = 2 * hstep;
  const unsigned ldsw = (unsigned)wid * 1024u;
  const int aoff = lds_byte(wr * 64 + fr, fq * 8), boff = lds_byte(wc * 32 + fr, fq * 8);
#define G_SA(b, h) (((b) * 2 + (h)) * HTB)
#define G_SB(b, h) ((4 + (b) * 2 + (h)) * HTB)
#define G_STAGE(bufoff, gbase) do { _Pragma("unroll") for (int _i = 0; _i < 2; ++_i) \
    __builtin_amdgcn_global_load_lds((const unsigned*)((const char*)(gbase) + voffA[_i]), (LAS unsigned*)(lds + (bufoff) + ldsw + _i * 8192), 16, 0, 0); } while (0)
#define G_LDA(dst, b, h) do { _Pragma("unroll") for (int m = 0; m < 4; ++m) _Pragma("unroll") for (int k = 0; k < 2; ++k) dst[m][k] = *(const LAS bf16x8*)(lds + G_SA(b, h) + aoff + m * 2048 + k * 1024); } while (0)
#define G_LDB(dst, b, h) do { _Pragma("unroll") for (int n = 0; n < 2; ++n) _Pragma("unroll") for (int k = 0; k < 2; ++k) dst[n][k] = *(const LAS bf16x8*)(lds + G_SB(b, h) + boff + n * 2048 + k * 1024); } while (0)
#define G_MMA(ai, bj, At_, Bt_) do { __builtin_amdgcn_s_setprio(1); _Pragma("unroll") for (int m = 0; m < 4; ++m) _Pragma("unroll") for (int n = 0; n < 2; ++n) _Pragma("unroll") for (int k = 0; k < 2; ++k) \
    acc[ai][bj][m][n] = __builtin_amdgcn_mfma_f32_16x16x32_bf16(Bt_[n][k], At_[m][k], acc[ai][bj][m][n], 0, 0, 0); __builtin_amdgcn_s_setprio(0); } while (0)
#define G_WAIT_V(n) asm volatile("s_waitcnt vmcnt(" #n ")" ::: "memory")
#define G_WAIT_L(n) asm volatile("s_waitcnt lgkmcnt(" #n ")" ::: "memory")
#define G_BAR __builtin_amdgcn_s_barrier()
#define G_SCHED __builtin_amdgcn_sched_barrier(0)
  Unit cur, nxt; int ui = 0;
  __syncthreads();
  if (!S.next(0, cur)) return;
  f32x4 acc[2][2][4][2];
#pragma unroll
  for (int a = 0; a < 2; ++a)
#pragma unroll
    for (int b = 0; b < 2; ++b)
#pragma unroll
      for (int m = 0; m < 4; ++m)
#pragma unroll
        for (int n = 0; n < 2; ++n) acc[a][b][m][n] = (f32x4){0.f, 0.f, 0.f, 0.f};
  bf16x8 At[4][2], B0[2][2], B1[2][2];
  const char* cA = (const char*)A + (size_t)cur.pm * tstep; const char* cB = (const char*)Bt + (size_t)cur.pn * tstep;
  G_STAGE(G_SB(0, 0), cB); G_STAGE(G_SA(0, 0), cA); G_STAGE(G_SB(0, 1), cB + hstep); G_STAGE(G_SA(0, 1), cA + hstep);
  if (wr == 1) G_BAR;
  G_WAIT_V(4); G_BAR;
  G_STAGE(G_SB(1, 0), cB + kstep); G_STAGE(G_SA(1, 0), cA + kstep); G_STAGE(G_SB(1, 1), cB + hstep + kstep);
  G_WAIT_V(6); G_BAR;
  for (;;) {
    const bool has_next = S.next(ui + 1, nxt);
    const char* nA = has_next ? (const char*)A + (size_t)nxt.pm * tstep : cA; const char* nB = has_next ? (const char*)Bt + (size_t)nxt.pn * tstep : cB;
    for (int t = 0; t < nt; t += 2) {
      const bool last = (t == nt - 2);
      const char* a1 = cA + (size_t)(t + 1) * kstep;
      const char* a2 = last ? nA : cA + (size_t)(t + 2) * kstep; const char* b2 = last ? nB : cB + (size_t)(t + 2) * kstep;
      const char* a3 = a2 + kstep; const char* b3 = b2 + kstep;
      G_LDB(B0, 0, 0); G_SCHED; G_LDA(At, 0, 0); G_STAGE(G_SA(1, 1), a1 + hstep);
      G_WAIT_L(8); G_BAR; G_WAIT_L(0); G_MMA(0, 0, At, B0); G_BAR; G_SCHED;
      G_LDB(B1, 0, 1); G_STAGE(G_SB(0, 0), b2);
      G_BAR; G_WAIT_L(0); G_MMA(0, 1, At, B1); G_BAR;
      G_LDA(At, 0, 1); G_STAGE(G_SA(0, 0), a2);
      G_BAR; G_WAIT_L(0); G_MMA(1, 0, At, B0); G_BAR; G_SCHED;
      G_STAGE(G_SB(0, 1), b2 + hstep);
      G_WAIT_V(6); G_BAR; G_MMA(1, 1, At, B1); G_BAR;
      G_LDB(B0, 1, 0); G_SCHED; G_LDA(At, 1, 0); G_STAGE(G_SA(0, 1), a2 + hstep);
      G_WAIT_L(8); G_BAR; G_WAIT_L(0); G_MMA(0, 0, At, B0); G_BAR; G_SCHED;
      G_LDB(B1, 1, 1); G_STAGE(G_SB(1, 0), b3);
      G_BAR; G_WAIT_L(0); G_MMA(0, 1, At, B1); G_BAR;
      G_LDA(At, 1, 1); G_STAGE(G_SA(1, 0), a3);
      G_BAR; G_WAIT_L(0); G_MMA(1, 0, At, B0); G_BAR; G_SCHED;
      G_STAGE(G_SB(1, 1), b3 + hstep);
      G_WAIT_V(6); G_BAR; G_MMA(1, 1, At, B1); G_BAR;
    }
    {
      int es_ = es; asm volatile("" : "+s"(es_));
      const EpiAny E = make_epi(p, es_, eis5, ej);
      E(acc, cur.pm * BM + (eis5 || es_ != 1 ? CTXL : 0), cur.pn * BM, wr, wc, fr, fq);
    }
    if (!has_next) break;
#pragma unroll
    for (int a = 0; a < 2; ++a)
#pragma unroll
      for (int b = 0; b < 2; ++b)
#pragma unroll
        for (int m = 0; m < 4; ++m)
#pragma unroll
          for (int n = 0; n < 2; ++n) acc[a][b][m][n] = (f32x4){0.f, 0.f, 0.f, 0.f};
    cur = nxt; cA = nA; cB = nB; ++ui;
  }
  G_WAIT_V(0);
  if (wr == 0) G_BAR;
  G_BAR;
#undef G_SA
#undef G_SB
#undef G_STAGE
#undef G_LDA
#undef G_LDB
#undef G_MMA
}

#define MFMA16(a, b, c) __builtin_amdgcn_mfma_f32_16x16x32_bf16(a, b, c, 0, 0, 0)
__device__ __forceinline__ void gemm_small_phase(const bf16_t* __restrict__ A, const bf16_t* __restrict__ Bt, int N, int K, const Params& p, int es, int eis5, int ej, int bid, int nblk, int tidx) {
  float* part = (float*)g_smem;
  const int tid = tidx, lane = tid & 63, wid = tid >> 6, fr = lane & 15, fq = lane >> 4;
  const int nsn = N >> 6;
  const int kw = K >> 3, nkb = kw >> 7;
#pragma unroll 1
  for (int u = bid; ; u += nblk) {
    const int b_ = u % nblk, k_ = u / nblk;
    int sm, sn;
    if ((nblk & 255) == 0) { const int b8 = b_ & 255; sm = (b8 >> 3) & 3; sn = (b8 & 7) + 8 * (b8 >> 5) + 64 * ((b_ >> 8) + (nblk >> 8) * k_); }
    else { sm = u & 3; sn = u >> 2; }
    if (sn >= nsn) { if ((nblk & 255) == 0 ? (64 * (nblk >> 8) * k_ >= nsn) : true) break; else continue; }
    f32x4 acc[4][4];
#pragma unroll
    for (int a = 0; a < 4; ++a)
#pragma unroll
      for (int b = 0; b < 4; ++b) acc[a][b] = (f32x4){0.f, 0.f, 0.f, 0.f};
    const bf16_t* ap = A + (size_t)(sm * 64 + (lane >> 2)) * K + wid * kw + (lane & 3) * 8;
    const bf16_t* bp = Bt + (size_t)(sn * 64 + (lane >> 2)) * K + wid * kw + (lane & 3) * 8;
    const int bsrc = (4 * fr + fq) * 4;
#pragma unroll 1
    for (int kb = 0; kb < nkb; ++kb) {
      bf16x8 af[4][4], bf[4][4];
      {
        u32x4 ra[4][4], rb[4][4];
#pragma unroll
        for (int ks = 0; ks < 4; ++ks)
#pragma unroll
          for (int i = 0; i < 4; ++i) {
            ra[ks][i] = *(const u32x4*)(ap + (size_t)i * 16 * K + kb * 128 + ks * 32);
            rb[ks][i] = *(const u32x4*)(bp + (size_t)i * 16 * K + kb * 128 + ks * 32);
          }
        __builtin_amdgcn_sched_barrier(0);
#pragma unroll
        for (int ks = 0; ks < 4; ++ks)
#pragma unroll
          for (int i = 0; i < 4; ++i) {
            u32x4 ta, tb;
#pragma unroll
            for (int w4 = 0; w4 < 4; ++w4) {
              ta[w4] = (unsigned)__builtin_amdgcn_ds_bpermute(bsrc, (int)ra[ks][i][w4]);
              tb[w4] = (unsigned)__builtin_amdgcn_ds_bpermute(bsrc, (int)rb[ks][i][w4]);
            }
            af[ks][i] = __builtin_bit_cast(bf16x8, ta); bf[ks][i] = __builtin_bit_cast(bf16x8, tb);
          }
      }
#pragma unroll
      for (int ks = 0; ks < 4; ++ks)
#pragma unroll
        for (int mi = 0; mi < 4; ++mi)
#pragma unroll
          for (int ni = 0; ni < 4; ++ni) acc[mi][ni] = MFMA16(bf[ks][ni], af[ks][mi], acc[mi][ni]);
    }
    __syncthreads();
#pragma unroll
    for (int mi = 0; mi < 4; ++mi)
#pragma unroll
      for (int ni = 0; ni < 4; ++ni) *(f32x4*)(part + (wid * 64 + mi * 16 + fr) * 68 + ni * 16 + fq * 4) = acc[mi][ni];
    __syncthreads();
    {
      const int rl = tid >> 3, c0 = (tid & 7) * 8;
      f32x4 s0 = (f32x4){0.f, 0.f, 0.f, 0.f}, s1 = s0;
#pragma unroll
      for (int w = 0; w < 8; ++w) { s0 += *(const f32x4*)(part + (w * 64 + rl) * 68 + c0); s1 += *(const f32x4*)(part + (w * 64 + rl) * 68 + c0 + 4); }
      const int row = sm * 64 + rl, col = sn * 64 + c0;
      bf16_t* Pp = (bf16_t*)(G(p.ws) + OFF_P);
      if (es == 1) {
        const int ld = eis5 ? 8192 : 20480;
        us8 o;
#pragma unroll
        for (int e = 0; e < 4; ++e) { o[e] = f2bf(s0[e]); o[4 + e] = f2bf(s1[e]); }
        *(us8*)(Pp + (size_t)row * ld + col) = o;
      } else if (es == 3) {
        const us8 yv = *(const us8*)((const bf16_t*)(G(p.ws) + OFF_YG) + (size_t)row * EI + col);
        const us8 zv = *(const us8*)(Pp + (size_t)row * 8192 + 4096 + col);
        const float* bias = G(p.s5_b_glu) + (size_t)ej * EI + col;
        const f32x4 b0 = *(const f32x4*)bias, b1 = *(const f32x4*)(bias + 4);
        us8 o;
#pragma unroll
        for (int e = 0; e < 8; ++e) {
          const float a = (e < 4 ? s0[e & 3] : s1[e & 3]) + (e < 4 ? b0[e & 3] : b1[e & 3]);
          const float y = bf2f(yv[e]), zz = bf2f(zv[e]);
          o[e] = f2bf(y * sigmoidf_(a) * (zz * sigmoidf_(zz)));
        }
        *(us8*)((bf16_t*)(G(p.ws) + OFF_V) + (size_t)row * EI + col) = o;
      } else {
        u32x4 o;
        o[0] = cvt_pk_bf16(s0[0], s0[1]); o[1] = cvt_pk_bf16(s0[2], s0[3]); o[2] = cvt_pk_bf16(s1[0], s1[1]); o[3] = cvt_pk_bf16(s1[2], s1[3]);
        *(u32x4*)((bf16_t*)(G(p.ws) + OFF_OX) + (size_t)row * DM + col) = o;
      }
    }
  }
  __syncthreads();
}

#define S5_NG 48
#define S5_USTR 1040
#define S5_HSTR 528

__device__ __forceinline__ float gelu_as(float v) {
  const float av = fabsf(v), t = __builtin_amdgcn_rcpf(av * 0.2316418882f + 1.0f);
  float q = t * 0.5307027145f + (-0.7265760135f); q = q * t + 0.7107068705f; q = q * t + (-0.142248368f); q = q * t + 0.127414796f; q = q * t;
  const float e = __builtin_amdgcn_exp2f((v * v) * (-0.72134752044f));
  const float m = v * (q * e);
  return v < 0.f ? m : v - m;
}
__device__ __forceinline__ unsigned pk_bf16(float lo, float hi) { return cvt_pk_bf16(lo, hi); }

__device__ void s5_phase(const Params& p, int j, int bid, int nblk, int tidx) {
  bf16_t* KcL = (bf16_t*)g_smem;
  float* pw = (float*)(g_smem + 32768);
  float* cc = pw + 2 * 33 * 64 * 2;
  unsigned char* UL = g_smem + 83200;
  unsigned char* HL = UL + 32 * S5_USTR;
  float* bbar = (float*)(g_smem + 133376);
#define S5P ((const bf16_t*)(G(p.ws) + OFF_P))
#define S5YG ((bf16_t*)(G(p.ws) + OFF_YG))
#pragma unroll 1
  for (int gi = bid; gi < 256; gi += nblk) {
    const int g = (gi & 7) * 32 + (gi >> 3);
    int tid = tidx; asm volatile("" : "+v"(tid));
    const int lane = tid & 63, wid = tid >> 6, fr = lane & 15, fq = lane >> 4;
#define S5S ((float*)(G(p.ws) + OFF_S5SCR + (size_t)g * S5_PER + S5_S))
#define S5HB ((bf16_t*)(G(p.ws) + OFF_S5SCR + (size_t)g * S5_PER + S5_H))
#define S5_TABLES() do { \
      for (int idx = tid; idx < 2 * 33 * 64; idx += NTHREADS) { \
        const int d_ = idx / (33 * 64), m_ = (idx >> 6) % 33, pp_ = idx & 63; \
        const size_t gi_ = ((size_t)(j * 2 + d_) * 256 + g); \
        const float lr_ = G(p.s5_lam_re)[gi_ * 64 + pp_], li_ = G(p.s5_lam_im)[gi_ * 64 + pp_]; \
        const float dt_ = expf(G(p.s5_log_dt)[gi_]); \
        const float mag_ = expf(lr_ * dt_ * (float)m_); \
        double rv_ = (double)li_ * (double)dt_ * 0.15915494309189535 * (double)m_; rv_ -= rint(rv_); \
        pw[idx * 2 + 0] = mag_ * __builtin_amdgcn_cosf((float)rv_); \
        pw[idx * 2 + 1] = mag_ * __builtin_amdgcn_sinf((float)rv_); } \
      for (int e_ = tid; e_ < 2 * 16 * 64; e_ += NTHREADS) { \
        const int d_ = e_ >> 10, c_ = (e_ >> 6) & 15, pp_ = e_ & 63; \
        const size_t ci_ = (((size_t)(j * 2 + d_) * 256 + g) * 16 + c_) * 64 + pp_; \
        cc[((d_ * 16 + c_) * 65 + pp_) * 2 + 0] = G(p.s5_c_re)[ci_]; cc[((d_ * 16 + c_) * 65 + pp_) * 2 + 1] = G(p.s5_c_im)[ci_]; } \
    } while (0)
    __syncthreads();
    S5_TABLES();
    __syncthreads();
    for (int e = tid; e < 2 * 64 * 16; e += NTHREADS) {
      const int d = e >> 10, pp = (e >> 4) & 63, c = e & 15;
      const size_t gi = ((size_t)(j * 2 + d) * 256 + g);
      const float lr = G(p.s5_lam_re)[gi * 64 + pp], li = G(p.s5_lam_im)[gi * 64 + pp];
      const float ar1 = pw[((d * 33 + 1) * 64 + pp) * 2], ai1 = pw[((d * 33 + 1) * 64 + pp) * 2 + 1];
      const float den = lr * lr + li * li;
      const float qr = ((ar1 - 1.0f) * lr + ai1 * li) / den;
      const float qi = (ai1 * lr - (ar1 - 1.0f) * li) / den;
      const float b_r = G(p.s5_b_re)[(gi * 64 + pp) * 16 + c], b_i = G(p.s5_b_im)[(gi * 64 + pp) * 16 + c];
      bbar[e * 2 + 0] = qr * b_r - qi * b_i;
      bbar[e * 2 + 1] = qr * b_i + qi * b_r;
    }
    __syncthreads();
    {
#pragma unroll 1
      for (int a = 0; a < 4; ++a) {
        const int tau = wid * 4 + a;
        f32x4 acc = (f32x4){0.f, 0.f, 0.f, 0.f};
#pragma unroll
        for (int d = 0; d < 2; ++d) {
#pragma unroll
          for (int ks = 0; ks < 4; ++ks) {
            const int p0 = ks * 16 + fq * 4;
            u32x4 afu, bfu;
#pragma unroll
            for (int i = 0; i < 4; ++i) {
              const float cr = cc[((d * 16 + fr) * 65 + p0 + i) * 2], ci = cc[((d * 16 + fr) * 65 + p0 + i) * 2 + 1];
              const float pr = pw[((d * 33 + tau) * 64 + p0 + i) * 2], pi = pw[((d * 33 + tau) * 64 + p0 + i) * 2 + 1];
              afu[i] = pk_bf16(cr * pr - ci * pi, -(cr * pi + ci * pr));
              bfu[i] = pk_bf16(bbar[((d * 64 + p0 + i) * 16 + fr) * 2], bbar[((d * 64 + p0 + i) * 16 + fr) * 2 + 1]);
            }
            acc = MFMA16(__builtin_bit_cast(bf16x8, afu), __builtin_bit_cast(bf16x8, bfu), acc);
          }
          if (tau != 0 || d == 1) {
            const int dl = (tau == 0) ? 0 : (d ? -tau : tau);
#pragma unroll
            for (int r = 0; r < 4; ++r) KcL[((dl + 31) * 16 + fq * 4 + r) * 16 + fr] = f2bf(acc[r]);
            acc = (f32x4){0.f, 0.f, 0.f, 0.f};
          }
        }
      }
    }
    float atr2[2][2];
    { const int dp = tid & 127; atr2[0][0] = atr2[1][0] = pw[(((dp >> 6) * 33 + 32) * 64 + (dp & 63)) * 2]; atr2[0][1] = atr2[1][1] = pw[(((dp >> 6) * 33 + 32) * 64 + (dp & 63)) * 2 + 1]; }
    {
      u32x4 w1f[2][16];
#pragma unroll
      for (int a = 0; a < 2; ++a) {
        const int R = (wid * 2 + a) * 16 + fr, dR = R >> 7, pp = (R & 127) >> 1, ri = R & 1;
        float br[8], bi[8];
#pragma unroll
        for (int i = 0; i < 8; ++i) { br[i] = bbar[((dR * 64 + pp) * 16 + (fq & 1) * 8 + i) * 2]; bi[i] = bbar[((dR * 64 + pp) * 16 + (fq & 1) * 8 + i) * 2 + 1]; }
#pragma unroll
        for (int ks = 0; ks < 16; ++ks) {
          const int s = ks * 2 + (fq >> 1), e = dR ? s : (31 - s);
          const float pr = pw[((dR * 33 + e) * 64 + pp) * 2], pi = pw[((dR * 33 + e) * 64 + pp) * 2 + 1];
#pragma unroll
          for (int i = 0; i < 4; ++i) {
            const float lo = ri ? (pr * bi[2 * i] + pi * br[2 * i]) : (pr * br[2 * i] - pi * bi[2 * i]);
            const float hi = ri ? (pr * bi[2 * i + 1] + pi * br[2 * i + 1]) : (pr * br[2 * i + 1] - pi * bi[2 * i + 1]);
            w1f[a][ks][i] = pk_bf16(lo, hi);
          }
          __builtin_amdgcn_sched_barrier(0);
        }
      }
      __syncthreads();
      us8 pu[4];
#define S5_ULOADX(ngx, R_) do { _Pragma("unroll") for (int i = 0; i < 4; ++i) { \
          const int piece = tid + NTHREADS * i, half = piece & 1, s = (piece >> 1) & 31, chl = piece >> 6; \
          const int ch = min((ngx) * 32 + chl, 263); \
          R_[i] = *(const us8*)(S5P + (size_t)(ch * 32 + s) * 8192 + g * 16 + half * 8); } } while (0)
#define S5_USTOREX(R_) do { _Pragma("unroll") for (int i = 0; i < 4; ++i) { \
          const int piece = tid + NTHREADS * i, half = piece & 1, s = (piece >> 1) & 31, chl = piece >> 6; \
          *(us8*)(UL + chl * S5_USTR + s * 32 + half * 16) = R_[i]; } } while (0)
#define S5_ULOAD(ngx) S5_ULOADX(ngx, pu)
#define S5_USTORE() S5_USTOREX(pu)
#define S5_STEP4(ng_, RC_) do { \
        S5_USTOREX(RC_); \
        __syncthreads(); \
        if ((ng_) + 1 < 9) S5_ULOADX((ng_) + 1, RC_); \
        f32x4 acc[2][2]; \
        _Pragma("unroll") for (int a = 0; a < 2; ++a) _Pragma("unroll") for (int q = 0; q < 2; ++q) acc[a][q] = (f32x4){0.f, 0.f, 0.f, 0.f}; \
        _Pragma("unroll") for (int ks = 0; ks < 16; ++ks) { \
          bf16x8 bf[2]; \
          _Pragma("unroll") for (int q = 0; q < 2; ++q) bf[q] = *(const bf16x8*)(UL + (q * 16 + fr) * S5_USTR + (ks * 2 + (fq >> 1)) * 32 + (fq & 1) * 16); \
          _Pragma("unroll") for (int a = 0; a < 2; ++a) _Pragma("unroll") for (int q = 0; q < 2; ++q) acc[a][q] = MFMA16(__builtin_bit_cast(bf16x8, w1f[a][ks]), bf[q], acc[a][q]); } \
        _Pragma("unroll") for (int a = 0; a < 2; ++a) _Pragma("unroll") for (int q = 0; q < 2; ++q) { \
            const int ch = (ng_) * 32 + q * 16 + fr; \
            if (ch < 264) *(f32x4*)(S5S + (size_t)ch * 256 + (wid * 2 + a) * 16 + fq * 4) = acc[a][q]; } \
        __syncthreads(); } while (0)
      S5_ULOADX(0, pu);
#pragma unroll 1
      for (int ng = 0; ng < 9; ++ng) { S5_STEP4(ng, pu); }
    }
    __syncthreads();
    {
      float* segend = (float*)UL;
      float* carry = segend + 8 * 128 * 2;
#pragma unroll 1
      for (int r = 0; r < 2; ++r) {
        const int item = tid + NTHREADS * r, dp = item & 127, d = dp >> 6, seg = item >> 7;
        const float* Sp = S5S + d * 128 + 2 * (dp & 63);
        float sr[33], si[33];
#pragma unroll
        for (int q = 0; q < 33; ++q) {
          const int pos = seg * 33 + q, k = d ? (pos < 8 ? 7 - pos : 271 - pos) : pos;
          sr[q] = Sp[(size_t)k * 256]; si[q] = Sp[(size_t)k * 256 + 1];
        }
        float hr = 0.f, hi = 0.f;
        const float ar = atr2[0][0], ai = atr2[0][1];
#pragma unroll
        for (int q = 0; q < 33; ++q) {
          const float nr = ar * hr - ai * hi + sr[q], ni = ar * hi + ai * hr + si[q];
          hr = nr; hi = ni;
        }
        segend[(seg * 128 + dp) * 2] = hr; segend[(seg * 128 + dp) * 2 + 1] = hi;
      }
      __syncthreads();
      if (tid < 128) {
        float pr = atr2[0][0], pi = atr2[0][1];
        float p2r = pr, p2i = pi;
#pragma unroll
        for (int q = 0; q < 5; ++q) { const float t = p2r * p2r - p2i * p2i; p2i = 2.f * p2r * p2i; p2r = t; }
        const float Ar = p2r * pr - p2i * pi, Ai = p2r * pi + p2i * pr;
        float cr = 0.f, ci = 0.f;
#pragma unroll
        for (int j = 0; j < 8; ++j) {
          carry[(j * 128 + tid) * 2] = cr; carry[(j * 128 + tid) * 2 + 1] = ci;
          const float er = segend[(j * 128 + tid) * 2], ei = segend[(j * 128 + tid) * 2 + 1];
          const float nr = Ar * cr - Ai * ci + er, ni = Ar * ci + Ai * cr + ei;
          cr = nr; ci = ni;
        }
      }
      __syncthreads();
#pragma unroll 1
      for (int r = 0; r < 2; ++r) {
        const int item = tid + NTHREADS * r, dp = item & 127, d = dp >> 6, seg = item >> 7;
        const float* Sp = S5S + d * 128 + 2 * (dp & 63);
        bf16_t* Hp = S5HB + d * 128 + 2 * (dp & 63);
        float sr[33], si[33];
#pragma unroll
        for (int q = 0; q < 33; ++q) {
          const int pos = seg * 33 + q, k = d ? (pos < 8 ? 7 - pos : 271 - pos) : pos;
          sr[q] = Sp[(size_t)k * 256]; si[q] = Sp[(size_t)k * 256 + 1];
        }
        float hr = carry[(seg * 128 + dp) * 2], hi = carry[(seg * 128 + dp) * 2 + 1];
        const float ar = atr2[0][0], ai = atr2[0][1];
#pragma unroll
        for (int q = 0; q < 33; ++q) {
          const int pos = seg * 33 + q, k = d ? (pos < 8 ? 7 - pos : 271 - pos) : pos;
          *(unsigned*)(Hp + (size_t)k * 256) = pk_bf16(hr, hi);
          const float nr = ar * hr - ai * hi + sr[q], ni = ar * hi + ai * hr + si[q];
          hr = nr; hi = ni;
        }
      }
    }
    __syncthreads();
#pragma unroll 1
    for (int half = 0; half < 2; ++half) {
      u32x4 w2f[2][8];
#pragma unroll
      for (int a = 0; a < 2; ++a) {
        const int t = wid * 4 + half * 2 + a;
#pragma unroll
        for (int kq = 0; kq < 8; ++kq) {
          const int d2 = kq >> 2, p0 = (kq & 3) * 16 + fq * 4, e = d2 ? (32 - t) : (t + 1);
#pragma unroll
          for (int i = 0; i < 4; ++i) {
            const float cr = cc[((d2 * 16 + fr) * 65 + p0 + i) * 2], ci = cc[((d2 * 16 + fr) * 65 + p0 + i) * 2 + 1];
            const float pr = pw[((d2 * 33 + e) * 64 + p0 + i) * 2], pi = pw[((d2 * 33 + e) * 64 + p0 + i) * 2 + 1];
            w2f[a][kq][i] = pk_bf16(cr * pr - ci * pi, -(cr * pi + ci * pr));
          }
          __builtin_amdgcn_sched_barrier(0);
        }
      }
      us8 pu[4], pv[4], phh[2], phv[2];
#define S5_HLOADX(ngx, R_) do { _Pragma("unroll") for (int i = 0; i < 2; ++i) { \
          const int piece = tid + NTHREADS * i, chl = piece >> 5, k8 = (piece & 31) * 8; \
          const int ch = min((ngx) * 32 + chl, 263); \
          R_[i] = *(const us8*)(S5HB + (size_t)ch * 256 + k8); } } while (0)
#define S5_HSTOREX(R_) do { _Pragma("unroll") for (int i = 0; i < 2; ++i) { \
          const int piece = tid + NTHREADS * i, chl = piece >> 5, k8 = (piece & 31) * 8; \
          *(us8*)(HL + chl * S5_HSTR + k8 * 2) = R_[i]; } } while (0)
#define S5_STEP6(ng_, RU_, RH_) do { \
        S5_USTOREX(RU_); S5_HSTOREX(RH_); \
        __syncthreads(); \
        if ((ng_) + 2 < 9) { S5_ULOADX((ng_) + 2, RU_); S5_HLOADX((ng_) + 2, RH_); } \
        f32x4 acc[2][2]; \
        _Pragma("unroll") for (int a = 0; a < 2; ++a) _Pragma("unroll") for (int q = 0; q < 2; ++q) acc[a][q] = (f32x4){0.f, 0.f, 0.f, 0.f}; \
        _Pragma("unroll 1") for (int ks = 0; ks < 16; ++ks) { \
          bf16x8 af[2], bf[2]; \
          const int s = ks * 2 + (fq >> 1); \
          _Pragma("unroll") for (int a = 0; a < 2; ++a) af[a] = *(const bf16x8*)(KcL + ((wid * 4 + half * 2 + a - s + 31) * 16 + fr) * 16 + (fq & 1) * 8); \
          _Pragma("unroll") for (int q = 0; q < 2; ++q) bf[q] = *(const bf16x8*)(UL + (q * 16 + fr) * S5_USTR + s * 32 + (fq & 1) * 16); \
          _Pragma("unroll") for (int a = 0; a < 2; ++a) _Pragma("unroll") for (int q = 0; q < 2; ++q) acc[a][q] = MFMA16(af[a], bf[q], acc[a][q]); } \
        _Pragma("unroll") for (int kq = 0; kq < 8; ++kq) { \
          bf16x8 bf[2]; \
          _Pragma("unroll") for (int q = 0; q < 2; ++q) bf[q] = *(const bf16x8*)(HL + (q * 16 + fr) * S5_HSTR + (kq * 32 + fq * 8) * 2); \
          _Pragma("unroll") for (int a = 0; a < 2; ++a) _Pragma("unroll") for (int q = 0; q < 2; ++q) acc[a][q] = MFMA16(__builtin_bit_cast(bf16x8, w2f[a][kq]), bf[q], acc[a][q]); } \
        const f32x4 dsk = *(const f32x4*)(G(p.s5_d) + (size_t)j * EI + g * 16 + fq * 4); \
        _Pragma("unroll") for (int a = 0; a < 2; ++a) _Pragma("unroll") for (int q = 0; q < 2; ++q) { \
            const int ch = (ng_) * 32 + q * 16 + fr; \
            if (ch < 264) { \
              const int t = wid * 4 + half * 2 + a; \
              const int row = ch * 32 + t; \
              const us4 uv = *(const us4*)(UL + (q * 16 + fr) * S5_USTR + t * 32 + fq * 8); \
              const float v0 = acc[a][q][0] + dsk[0] * bf2f(uv[0]); \
              const float v1 = acc[a][q][1] + dsk[1] * bf2f(uv[1]); \
              const float v2 = acc[a][q][2] + dsk[2] * bf2f(uv[2]); \
              const float v3 = acc[a][q][3] + dsk[3] * bf2f(uv[3]); \
              unsigned __attribute__((ext_vector_type(2))) o; \
              o[0] = cvt_pk_bf16(gelu_as(v0), gelu_as(v1)); o[1] = cvt_pk_bf16(gelu_as(v2), gelu_as(v3)); \
              *(unsigned __attribute__((ext_vector_type(2)))*)(S5YG + (size_t)row * EI + g * 16 + fq * 4) = o; } } \
        __syncthreads(); } while (0)
      S5_ULOADX(0, pu); S5_HLOADX(0, phh); S5_ULOADX(1, pv); S5_HLOADX(1, phv);
#pragma unroll 1
      for (int ng = 0; ng < 8; ng += 2) { S5_STEP6(ng, pu, phh); S5_STEP6(ng + 1, pv, phv); }
      S5_STEP6(8, pu, phh);
    }
#undef S5_TABLES
  }
}

__device__ __forceinline__ float fexp(float x) { return __expf(x); }
__device__ __forceinline__ float frcp(float x) { return __builtin_amdgcn_rcpf(x); }

__device__ void hgrn_pre_phase(const Params& p, int j, int bid, int nblk, int tidx) {
  const int tid = tidx, lane = tid & 63, wid = tid >> 6, fr = lane & 15, fq = lane >> 4;
  float* gbuf = (float*)g_smem;
  float* tot = gbuf + 64 * 128;
  float* cem = tot + 512;
  float* celm = cem + 128;
  bf16_t* qe = (bf16_t*)(celm + 128);
  bf16_t* ke = qe + 64 * 136;
  bf16_t* kbT = ke + 64 * 136;
  bf16_t* vT = kbT + 128 * 72;
  bf16_t* sc = vT + 128 * 72;
  bf16_t* P = (bf16_t*)(G(p.ws) + OFF_P);
  bf16_t* QB = (bf16_t*)(G(p.ws) + OFF_QB);
  bf16_t* VT = (bf16_t*)(G(p.ws) + OFF_VT);
  float* DEC = (float*)(G(p.ws) + OFF_DEC);
  const int tau = tid >> 3, dk0 = (tid & 7) * 16, swz = (tid & 7) * 8;
  us8 nf0, nf1, nq0, nq1, nv0, nv1;
  float lbv[16];
#pragma unroll
  for (int e = 0; e < 16; ++e) lbv[e] = 0.f;
  int cur_hd = -1;
  if (bid < 8448) {
    const int item = bid, d = item & 1, h = (item >> 1) & 31, chunk = item >> 6;
    const size_t row = (size_t)chunk * 64 + (d ? 63 - tau : tau);
    const bf16_t* rp = P + row * 20480 + h * 128 + dk0;
    nf0 = *(const us8*)(rp + (1 + d) * EI); nf1 = *(const us8*)(rp + (1 + d) * EI + 8);
    nq0 = *(const us8*)(rp + 3 * EI); nq1 = *(const us8*)(rp + 3 * EI + 8);
    nv0 = *(const us8*)(rp); nv1 = *(const us8*)(rp + 8);
  }
#pragma unroll 1
  for (int item = bid; item < 8448; item += nblk) {
    const int d = item & 1, h = (item >> 1) & 31, chunk = item >> 6;
    bf16_t* O = (bf16_t*)(G(p.ws) + OFF_OFB) + (size_t)d * MROWS * EI;
    float kk[16], qq[16];
    {
      const us8 cf0 = nf0, cf1 = nf1, cq0 = nq0, cq1 = nq1, cv0 = nv0, cv1 = nv1;
      if (j != 0 && (h * 2 + d) != cur_hd) {
        cur_hd = h * 2 + d;
#pragma unroll
        for (int e = 0; e < 16; ++e) {
          const float l0 = G(p.hgrn_lb)[(size_t)(d * 2 + 0) * EI + h * 128 + dk0 + e];
          const float l1 = G(p.hgrn_lb)[(size_t)(d * 2 + 1) * EI + h * 128 + dk0 + e];
          const float mx = fmaxf(l0, l1);
          const float e0 = expf(l0 - mx), e1 = expf(l1 - mx);
          const float p0 = e0 / (e0 + e1), p1 = e1 / (e0 + e1);
          lbv[e] = (p0 + p1) - p0;
        }
      }
#pragma unroll
      for (int e = 0; e < 16; ++e) {
        float f = bf2f(e < 8 ? cf0[e & 7] : cf1[e & 7]);
        f = fminf(fmaxf(f, -30.f), 30.f);
        const float ef = fexp(-f), sg = frcp(1.0f + ef);
        const float lb = lbv[e];
        const float gg = (j == 0) ? -__logf(1.0f + ef) : __logf(lb + (1.0f - lb) * sg);
        gbuf[tau * 128 + dk0 + e] = gg;
        kk[e] = (1.0f - lb) * ef * sg;
        float qv = bf2f(e < 8 ? cq0[e & 7] : cq1[e & 7]);
        const float qc = fminf(fmaxf(qv, -30.f), 30.f);
        qq[e] = qv * frcp(1.0f + fexp(-qc));
        vT[(dk0 + e) * 72 + (tau ^ swz)] = (e < 8 ? cv0[e & 7] : cv1[e & 7]);
      }
    }
    if (item + nblk < 8448) {
      const int it2 = item + nblk, d2 = it2 & 1, h2 = (it2 >> 1) & 31, c2 = it2 >> 6;
      const size_t row = (size_t)c2 * 64 + (d2 ? 63 - tau : tau);
      const bf16_t* rp = P + row * 20480 + h2 * 128 + dk0;
      nf0 = *(const us8*)(rp + (1 + d2) * EI); nf1 = *(const us8*)(rp + (1 + d2) * EI + 8);
      nq0 = *(const us8*)(rp + 3 * EI); nq1 = *(const us8*)(rp + 3 * EI + 8);
      nv0 = *(const us8*)(rp); nv1 = *(const us8*)(rp + 8);
    }
    __syncthreads();
    {
      const int dkc = tid & 127, part = tid >> 7;
      float loc[16], run = 0.f;
#pragma unroll
      for (int t = 0; t < 16; ++t) { run += gbuf[(part * 16 + t) * 128 + dkc]; loc[t] = run; }
      tot[part * 128 + dkc] = run;
      __syncthreads();
      float off = 0.f;
      for (int pp = 0; pp < part; ++pp) off += tot[pp * 128 + dkc];
#pragma unroll
      for (int t = 0; t < 16; ++t) gbuf[(part * 16 + t) * 128 + dkc] = loc[t] + off;
    }
    __syncthreads();
    if (tid < 128) {
      const float bm = gbuf[31 * 128 + tid], bl = gbuf[63 * 128 + tid];
      cem[tid] = fexp(bm); celm[tid] = fexp(bl - bm);
      DEC[((size_t)(chunk * 32 + h) * 2 + d) * 128 + tid] = fexp(bl);
    }
    __syncthreads();
    {
      us8 oq[2], ok[2], ob[2];
      const int rn = d ? 63 - tau : tau;
#pragma unroll
      for (int e = 0; e < 16; ++e) {
        const float bc = gbuf[tau * 128 + dk0 + e], bm = gbuf[31 * 128 + dk0 + e];
        const float E1 = fexp(fminf(fmaxf(bc - bm, -80.f), 80.f)), R1 = frcp(E1);
        const float qev = qq[e] * E1, kev = kk[e] * R1;
        oq[e >> 3][e & 7] = f2bf(qev);
        ok[e >> 3][e & 7] = f2bf(kev);
        ob[e >> 3][e & 7] = f2bf(qev * cem[dk0 + e]);
        kbT[(dk0 + e) * 72 + (rn ^ swz)] = f2bf(kev * celm[dk0 + e]);
      }
      *(us8*)(qe + tau * 136 + dk0) = oq[0]; *(us8*)(qe + tau * 136 + dk0 + 8) = oq[1];
      *(us8*)(ke + tau * 136 + dk0) = ok[0]; *(us8*)(ke + tau * 136 + dk0 + 8) = ok[1];
      {
        bf16_t* qbase = QB + (size_t)((d * 132 + chunk) * 32 + h) * 8192;
        const int k8 = dk0 >> 3;
        *(us8*)(qbase + ((tau >> 4) * 4 + (k8 >> 2)) * 512 + ((tau & 15) + 16 * (k8 & 3)) * 8) = ob[0];
        *(us8*)(qbase + ((tau >> 4) * 4 + ((k8 + 1) >> 2)) * 512 + ((tau & 15) + 16 * ((k8 + 1) & 3)) * 8) = ob[1];
      }
    }
    __syncthreads();
    {
      const int mt = wid >> 1;
#pragma unroll
      for (int nn = 0; nn < 2; ++nn) {
        const int nt2 = (wid & 1) * 2 + nn;
        f32x4 a4 = (f32x4){0.f, 0.f, 0.f, 0.f};
#pragma unroll
        for (int ks = 0; ks < 4; ++ks) {
          const bf16x8 a = *(const bf16x8*)(qe + (mt * 16 + fr) * 136 + ks * 32 + fq * 8);
          const bf16x8 b = *(const bf16x8*)(ke + (nt2 * 16 + fr) * 136 + ks * 32 + fq * 8);
          a4 = MFMA16(a, b, a4);
        }
        const int s = nt2 * 16 + fr;
#pragma unroll
        for (int r = 0; r < 4; ++r) {
          const int t = mt * 16 + fq * 4 + r;
          sc[t * 72 + s] = (s <= t) ? f2bf(a4[r]) : (bf16_t)0;
        }
      }
    }
    __syncthreads();
    {
      bf16x8 av[2];
#pragma unroll
      for (int ks = 0; ks < 2; ++ks) av[ks] = *(const bf16x8*)(vT + (wid * 16 + fr) * 72 + ((ks * 32 + fq * 8) ^ ((wid & 7) * 8)));
#pragma unroll
      for (int jt = 0; jt < 4; ++jt) {
        f32x4 a4 = (f32x4){0.f, 0.f, 0.f, 0.f};
#pragma unroll
        for (int ks = 0; ks < 2; ++ks) {
          const bf16x8 b = *(const bf16x8*)(sc + (jt * 16 + fr) * 72 + ks * 32 + fq * 8);
          a4 = MFMA16(av[ks], b, a4);
        }
        unsigned __attribute__((ext_vector_type(2))) o;
        o[0] = cvt_pk_bf16(a4[0], a4[1]); o[1] = cvt_pk_bf16(a4[2], a4[3]);
        *(unsigned __attribute__((ext_vector_type(2)))*)((bf16_t*)(G(p.ws) + OFF_OFB) + (size_t)((d * 132 + chunk) * 32 + h) * 8192 + ((wid * 4 + jt) * 64 + lane) * 4) = o;
      }
#pragma unroll
      for (int i2 = 0; i2 < 2; ++i2) {
        const int piece = tid + 512 * i2, blk_ = piece >> 6, ln_ = piece & 63;
        const int dk = (blk_ >> 1) * 16 + (ln_ & 15), r8i = (blk_ & 1) * 4 + (ln_ >> 4), r8 = r8i * 8;
        const us8 kv = *(const us8*)(kbT + dk * 72 + (r8 ^ (((dk >> 4) & 7) * 8)));
        const int fo = piece * 16;
        *(us8*)(P + ((size_t)chunk * 64 + (fo >> 8)) * 20480 + (1 + d) * EI + h * 128 + ((fo & 255) >> 1)) = kv;
        if (d == 0) {
          const us8 vv = *(const us8*)(vT + dk * 72 + (r8 ^ (((dk >> 4) & 7) * 8)));
          *(us8*)(VT + (size_t)(chunk * 32 + h) * 8192 + (fo >> 1)) = vv;
        }
      }
    }
    __syncthreads();
  }
}

__device__ void hgrn_seq_phase(const Params& p, int j, int bid, int nblk, int tidx) {
  const int tid = tidx, lane = tid & 63, wid = tid >> 6, fr = lane & 15, fq = lane >> 4;
  bf16_t* ST = (bf16_t*)g_smem;
  const bf16_t* P = (const bf16_t*)(G(p.ws) + OFF_P);
  const bf16_t* QB = (const bf16_t*)(G(p.ws) + OFF_QB);
  const bf16_t* VT = (const bf16_t*)(G(p.ws) + OFF_VT);
  const float* DEC = (const float*)(G(p.ws) + OFF_DEC);
  const int it = wid & 1, jt = wid >> 1;
#pragma unroll 1
  for (int item = bid; item < 256; item += nblk) {
    const int vs = (item >> 3) & 3, hd = (item & 7) + 8 * (item >> 5), h = hd >> 1, d = hd & 1;
    bf16_t* O = (bf16_t*)(G(p.ws) + OFF_OFB) + (size_t)d * MROWS * EI;
    __syncthreads();
    for (int i = tid; i < 2 * 32 * 136; i += NTHREADS) ST[i] = 0;
    f32x4 accS[2];
    accS[0] = (f32x4){0.f, 0.f, 0.f, 0.f}; accS[1] = (f32x4){0.f, 0.f, 0.f, 0.f};
    bf16x8 Aqb[4], Akb[2], Avt[2][2]; f32x4 Adc; us4 Aoi;
    bf16x8 Bqb[4], Bkb[2], Bvt[2][2]; f32x4 Bdc; us4 Boi;
    bf16x8 Cqb[4], Ckb[2], Cvt[2][2]; f32x4 Cdc; us4 Coi;
    const int dkr = 16 * wid + fr;
    const int tq = jt * 16 + fr;
#define CHAIN(n_) (d ? ((n_) < 4 ? 3 - (n_) : 135 - (n_)) : (n_))
#define HSEQ_LOAD(c, S_) do { \
      const bf16_t* qp_ = QB + (size_t)((d * 132 + (c)) * 32 + h) * 8192 + jt * 4 * 512 + lane * 8; \
      _Pragma("unroll") for (int ks = 0; ks < 4; ++ks) S_##qb[ks] = *(const bf16x8*)(qp_ + ks * 512); \
      _Pragma("unroll") for (int ks = 0; ks < 2; ++ks) S_##kb[ks] = *(const bf16x8*)(P + ((size_t)(c) * 64 + (wid * 2 + ks) * 4 + fq) * 20480 + (1 + d) * EI + h * 128 + fr * 8); \
      _Pragma("unroll") for (int nn = 0; nn < 2; ++nn) { \
        const bf16_t* vp_ = VT + (size_t)((c) * 32 + h) * 8192 + ((vs * 2 + nn) * 2) * 512 + lane * 8; \
        _Pragma("unroll") for (int ks = 0; ks < 2; ++ks) S_##vt[nn][ks] = *(const bf16x8*)(vp_ + ks * 512); } \
      S_##dc = *(const f32x4*)(DEC + ((size_t)((c) * 32 + h) * 2 + d) * 128 + 16 * wid + fq * 4); \
    } while (0)
#define HSEQ_STEP(n_, C_, L_) do { \
      const int n = (n_); const int chunk = CHAIN(n); const int cur = n & 1; \
      if (n + 2 < 132) { const int nc = CHAIN(n + 2); HSEQ_LOAD(nc, L_); } \
      { f32x4 a4 = (f32x4){0.f, 0.f, 0.f, 0.f}; \
        const bf16_t* stc = ST + cur * 32 * 136; \
        _Pragma("unroll") for (int ks = 0; ks < 4; ++ks) { \
          const bf16x8 a = *(const bf16x8*)(stc + (it * 16 + fr) * 136 + ks * 32 + fq * 8); \
          a4 = MFMA16(a, C_##qb[ks], a4); } \
        us4 o; \
        _Pragma("unroll") for (int r = 0; r < 4; ++r) o[r] = f2bf(a4[r] + bf2f(oic[(n_) - n0][r])); \
        obuf[(n_) - n0] = o; } \
      { bf16_t* stn = ST + (cur ^ 1) * 32 * 136; \
        _Pragma("unroll") for (int nn = 0; nn < 2; ++nn) { \
          _Pragma("unroll") for (int r = 0; r < 4; ++r) accS[nn][r] *= C_##dc[r]; \
          _Pragma("unroll") for (int ks = 0; ks < 2; ++ks) accS[nn] = MFMA16(C_##kb[ks], C_##vt[nn][ks], accS[nn]); \
          us4 o; \
          _Pragma("unroll") for (int r = 0; r < 4; ++r) o[r] = f2bf(accS[nn][r]); \
          *(us4*)(stn + (nn * 16 + fr) * 136 + wid * 16 + fq * 4) = o; } } \
      asm volatile("s_waitcnt lgkmcnt(0)" ::: "memory"); __builtin_amdgcn_s_barrier(); asm volatile("" ::: "memory"); \
    } while (0)
    us4 oin[6];
#pragma unroll
    for (int k = 0; k < 6; ++k) {
      const int ck = CHAIN(k);
      oin[k] = *(const us4*)((const bf16_t*)(G(p.ws) + OFF_OFB) + (size_t)((d * 132 + ck) * 32 + h) * 8192 + (((vs * 2 + it) * 4 + jt) * 64 + lane) * 4);
    }
    { const int c0 = CHAIN(0); HSEQ_LOAD(c0, A); const int c1 = CHAIN(1); HSEQ_LOAD(c1, B); }
    __syncthreads();
#pragma unroll 1
    for (int n0 = 0; n0 < 132; n0 += 6) {
      us4 obuf[6], oic[6];
#pragma unroll
      for (int k = 0; k < 6; ++k) oic[k] = oin[k];
      if (n0 + 6 < 132) {
#pragma unroll
        for (int k = 0; k < 6; ++k) {
          const int ck = CHAIN(n0 + 6 + k);
          oin[k] = *(const us4*)((const bf16_t*)(G(p.ws) + OFF_OFB) + (size_t)((d * 132 + ck) * 32 + h) * 8192 + (((vs * 2 + it) * 4 + jt) * 64 + lane) * 4);
        }
      }
      HSEQ_STEP(n0, A, C);
      HSEQ_STEP(n0 + 1, B, A);
      HSEQ_STEP(n0 + 2, C, B);
      HSEQ_STEP(n0 + 3, A, C);
      HSEQ_STEP(n0 + 4, B, A);
      HSEQ_STEP(n0 + 5, C, B);
#pragma unroll
      for (int k = 0; k < 6; ++k) {
        const int ck = CHAIN(n0 + k);
        *(us4*)((bf16_t*)(G(p.ws) + OFF_OFB) + (size_t)((d * 132 + ck) * 32 + h) * 8192 + (((vs * 2 + it) * 4 + jt) * 64 + lane) * 4) = obuf[k];
      }
    }
#undef HSEQ_STEP
#undef CHAIN
#undef HSEQ_LOAD
  }
}

__device__ void hgrn_finish_phase(const Params& p, int j, int bid, int nblk, int tidx) {
  const int tid = tidx, lane = tid & 63, wid = tid >> 6, fr = lane & 15, fq = lane >> 4;
  const bf16_t* OF = (const bf16_t*)(G(p.ws) + OFF_OFB);
  const bf16_t* P = (const bf16_t*)(G(p.ws) + OFF_P);
  bf16_t* OH = (bf16_t*)(G(p.ws) + OFF_OH);
  const float* onorm = G(p.hgrn_norm) + (size_t)j * EI;
  float* tb = (float*)g_smem + wid * 2048;
#pragma unroll 1
  for (int wi = bid * 8 + wid; wi < 132 * 32 * 4; wi += nblk * 8) {
    const int jt = wi & 3, h = (wi >> 2) & 31, chunk = wi >> 7;
    const bf16_t* fb = OF + (size_t)((0 * 132 + chunk) * 32 + h) * 8192 + (jt * 64 + lane) * 4;
    const bf16_t* bb = OF + (size_t)((1 * 132 + chunk) * 32 + h) * 8192 + ((3 - jt) * 64 + (15 - fr) + 16 * fq) * 4;
    float o[8][4], ss = 0.f;
#pragma unroll
    for (int pp = 0; pp < 8; ++pp) {
      const us4 a = *(const us4*)(fb + pp * 1024), b = *(const us4*)(bb + pp * 1024);
#pragma unroll
      for (int e = 0; e < 4; ++e) { o[pp][e] = bf2f(a[e]) + bf2f(b[e]); ss += o[pp][e] * o[pp][e]; }
    }
    ss += __shfl_xor(ss, 16); ss += __shfl_xor(ss, 32);
    const float inv = rsqrtf(ss * (1.0f / 128.0f) + 1e-6f);
#pragma unroll
    for (int pp = 0; pp < 8; ++pp) {
      f32x4 t;
#pragma unroll
      for (int e = 0; e < 4; ++e) t[e] = o[pp][e] * inv;
      *(f32x4*)(tb + fr * 128 + (((pp * 4 + fq) ^ (fr & 7)) << 2)) = t;
    }
    const int c8 = (lane & 15) * 8, ch = h * 128 + c8;
    const f32x4 n0 = *(const f32x4*)(onorm + ch), n1 = *(const f32x4*)(onorm + ch + 4);
#pragma unroll
    for (int ps = 0; ps < 4; ++ps) {
      const int rr = ps * 4 + (lane >> 4);
      const f32x4 t0 = *(const f32x4*)(tb + rr * 128 + ((((lane & 15) * 2) ^ (rr & 7)) << 2));
      const f32x4 t1 = *(const f32x4*)(tb + rr * 128 + ((((lane & 15) * 2 + 1) ^ (rr & 7)) << 2));
      const size_t row = (size_t)chunk * 64 + jt * 16 + rr;
      const us8 z = *(const us8*)(P + row * 20480 + 4 * EI + ch);
      u32x4 out;
#pragma unroll
      for (int e = 0; e < 4; ++e) {
        const float v0 = (e < 2 ? t0[2 * e] * n0[2 * e] : t1[2 * e - 4] * n1[2 * e - 4]);
        const float v1 = (e < 2 ? t0[2 * e + 1] * n0[2 * e + 1] : t1[2 * e - 3] * n1[2 * e - 3]);
        const float z0 = bf2f(z[2 * e]), z1 = bf2f(z[2 * e + 1]);
        out[e] = cvt_pk_bf16(v0 * (z0 * sigmoidf_(z0)), v1 * (z1 * sigmoidf_(z1)));
      }
      *(u32x4*)(OH + row * EI + ch) = out;
    }
  }
}

#define NPHASES 24
__device__ __forceinline__ void decode_phase(int ph, int& layer, int& kind) {
  if (ph == 0) { layer = 0; kind = 0; return; }
  if (ph == 23) { layer = 4; kind = 1; return; }
  int q = ph - 1;
  if (q >= 11) { q -= 11; layer = 2; } else layer = 0;
  if (q < 5) { kind = (q == 0) ? 1 : (q == 1) ? 2 : (q == 2) ? 3 : (q == 3) ? 4 : 5; }
  else { q -= 5; layer += 1; kind = (q == 0) ? 1 : (q == 1) ? 2 : (q == 2) ? 6 : (q == 3) ? 7 : (q == 4) ? 8 : 5; }
}
__device__ void run_phase(const Params& p, int ph, int bid, int nblk, int tidx) {
  int i, kind; decode_phase(ph, i, kind);
#ifdef ONLYK
  if (!((ONLYK >> kind) & 1)) return;
#endif
  const int j = (i >> 1) & 1;
  const bool is_s5 = (i & 1) == 0;
  if (kind == 0) { adaln_phase(p, bid, nblk, tidx); __syncthreads(); convert_phase(p, bid, nblk, tidx); return; }
  if (kind == 1) { norm_phase(p, i, bid, nblk, tidx); return; }
  if (kind == 3) { s5_phase(p, j, bid, nblk, tidx); return; }
  if (kind == 6) { hgrn_pre_phase(p, j, bid, nblk, tidx); return; }
  if (kind == 7) { hgrn_seq_phase(p, j, bid, nblk, tidx); return; }
  if (kind == 8) { hgrn_finish_phase(p, j, bid, nblk, tidx); return; }
  const int s = (kind == 2) ? 1 : (kind == 4) ? 3 : 4;
  const bf16_t* A; const bf16_t* Bt; int N, K;
  if (s == 1) {
    A = (const bf16_t*)(G(p.ws) + OFF_HX); K = 2048;
    if (is_s5) { Bt = (const bf16_t*)(G(p.ws) + OFF_WS5IN + j * SZ_WS5IN); N = 8192; }
    else { Bt = (const bf16_t*)(G(p.ws) + OFF_WHIN + j * SZ_WHIN); N = 20480; }
  } else if (s == 3) {
    A = (const bf16_t*)(G(p.ws) + OFF_YG); Bt = (const bf16_t*)(G(p.ws) + OFF_WGLU + j * SZ_WGLU); N = 4096; K = 4096;
  } else {
    A = is_s5 ? (const bf16_t*)(G(p.ws) + OFF_V) : (const bf16_t*)(G(p.ws) + OFF_OH);
    Bt = is_s5 ? (const bf16_t*)(G(p.ws) + OFF_WS5OUT + j * SZ_WOUT) : (const bf16_t*)(G(p.ws) + OFF_WHOUT + j * SZ_WOUT);
    N = 2048; K = 4096;
  }
#ifndef RPTB
#define RPTB 1
#endif
#ifndef RPTS
#define RPTS 1
#endif
  const bool ctx_big = (s == 1) && !is_s5;
  gemm_phase(ctx_big ? A : A + (size_t)CTXL * K, Bt, ctx_big ? MROWS : SEQL, N, K, p, s, is_s5 ? 1 : 0, j, bid, nblk, tidx);
  if (!ctx_big && !(s == 4 && i == 3)) gemm_small_phase(A, Bt, N, K, p, s, is_s5 ? 1 : 0, j, bid, nblk, tidx);
}

#define XB_TMO      128
#define XB_XCNT(j)  (256  + 64 * (j))
#define XB_XSUB(j)  (1280 + 64 * (j))
#define XB_XGEN(j)  (2304 + 64 * (j))
#define XB_TOP      3328
#define XB_TOPGEN   3392
#define XCD_BAR_WORDS 3456
#define XB_SPIN_CAP (1u << 18)
__device__ __forceinline__ unsigned xb_ld(unsigned* p) { return __hip_atomic_load(p, __ATOMIC_RELAXED, __HIP_MEMORY_SCOPE_AGENT); }
__device__ __forceinline__ unsigned xb_add(unsigned* p, unsigned v) { return __hip_atomic_fetch_add(p, v, __ATOMIC_RELAXED, __HIP_MEMORY_SCOPE_AGENT); }
__device__ __forceinline__ unsigned xb_xcc_id() { return (unsigned)__builtin_amdgcn_s_getreg((3 << 11) | 20) & 0xFu; }
#define XB_SPIN(cond, bar) do { unsigned _sp = 0; while (cond) { __builtin_amdgcn_s_sleep(1); \
    if ((++_sp & 255u) == 0u) { if (xb_ld(&(bar)[XB_TMO])) break; if (_sp > XB_SPIN_CAP) { atomicAdd(&(bar)[XB_TMO], 1u); break; } } } } while (0)
__device__ __forceinline__ void xcd_barrier_complete(unsigned* bar, unsigned x, unsigned G, unsigned& nloc, unsigned& nx) {
  unsigned sum, cnt, mine, sp = 0u;
  for (;;) {
    sum = 0u; cnt = 0u; mine = 0u;
#pragma unroll
    for (unsigned j = 0; j < 16; ++j) { const unsigned c = xb_ld(&bar[XB_XCNT(j)]); sum += c; cnt += (c > 0u) ? 1u : 0u; mine = (j == x) ? c : mine; }
    if (sum == G) break;
    __builtin_amdgcn_s_sleep(1);
    if ((++sp & 255u) == 0u) { if (xb_ld(&bar[XB_TMO])) break; if (sp > XB_SPIN_CAP) { atomicAdd(&bar[XB_TMO], 1u); break; } }
  }
  nloc = mine > 0u ? mine : 1u; nx = cnt > 0u ? cnt : 1u;
}
__device__ __forceinline__ void xcd_barrier(unsigned* bar, volatile LAS unsigned* st, bool leader_thread, unsigned G) {
  asm volatile("s_waitcnt vmcnt(0)" ::: "memory");
  __syncthreads();
  if (leader_thread) {
    const unsigned x = xb_xcc_id();
    __builtin_amdgcn_s_waitcnt(0);
    unsigned nloc = st[0], nx = st[1];
    if (nloc == 0u) { xcd_barrier_complete(bar, x, G, nloc, nx); st[0] = nloc; st[1] = nx; }
    const unsigned old = xb_add(&bar[XB_XSUB(x)], 1u);
    const unsigned gen = old / nloc;
    if (old + 1u == (gen + 1u) * nloc) {
      __builtin_amdgcn_fence(__ATOMIC_RELEASE, "agent");
      asm volatile("s_waitcnt vmcnt(0)" ::: "memory");
      const unsigned og = xb_add(&bar[XB_TOP], 1u);
      const unsigned tg = og / nx;
      if (og + 1u == (tg + 1u) * nx) xb_add(&bar[XB_TOPGEN], 1u);
      else XB_SPIN(xb_ld(&bar[XB_TOPGEN]) == tg, bar);
      __builtin_amdgcn_fence(__ATOMIC_ACQUIRE, "agent");
      xb_add(&bar[XB_XGEN(x)], 1u);
      asm volatile("s_waitcnt vmcnt(0)" ::: "memory");
    } else {
      XB_SPIN(xb_ld(&bar[XB_XGEN(x)]) == gen, bar);
      __builtin_amdgcn_fence(__ATOMIC_ACQUIRE, "agent");
      asm volatile("s_waitcnt vmcnt(0)" ::: "memory");
    }
  }
  __syncthreads();
}

__global__ void __launch_bounds__(NTHREADS) mega(Params p, int ph_lo, int ph_hi) {
  cg::grid_group grid = cg::this_grid();
  const int wave_id = __builtin_amdgcn_readfirstlane((int)(threadIdx.x >> 6));
  {
    volatile LAS unsigned* st0 = (volatile LAS unsigned*)((LAS unsigned char*)g_smem + 149760);
    if (threadIdx.x < 2) st0[threadIdx.x] = 0u;
    if (blockIdx.x == 0) { unsigned* bw = (unsigned*)(G(p.ws) + OFF_BAR); for (int i = threadIdx.x; i < XCD_BAR_WORDS; i += NTHREADS) bw[i] = 0u; }
    __syncthreads();
  }
#pragma unroll 1
  for (int ph = ph_lo; ph < ph_hi; ++ph) {
    const Params* pp = (const Params*)__builtin_amdgcn_kernarg_segment_ptr();
    asm volatile("" : "+s"(pp));
    int wv = wave_id; asm volatile("" : "+s"(wv));
    int tidx = wv * 64 + (int)__builtin_amdgcn_mbcnt_hi(~0u, __builtin_amdgcn_mbcnt_lo(~0u, 0u));
    asm volatile("" : "+v"(tidx));
    run_phase(*pp, ph, blockIdx.x, gridDim.x, tidx);
    if (ph + 1 < ph_hi) {
      if (ph == ph_lo) {
        grid.sync();
        if (threadIdx.x == 0) (void)xb_add((unsigned*)(G(pp->ws) + OFF_BAR) + XB_XCNT(xb_xcc_id()), 1u);
      }
      else xcd_barrier((unsigned*)(G(pp->ws) + OFF_BAR), (volatile LAS unsigned*)((LAS unsigned char*)g_smem + 149760), tidx == 0, gridDim.x);
    }
  }
}

extern "C" void kernel_launch(void* const* d_in, const int* in_sizes, int n_in, void* d_out, int out_size, void* d_ws, size_t ws_size,
                              hipStream_t stream) {
  static int grid_blocks = 0;
  if (!grid_blocks) {
    hipFuncSetAttribute((const void*)mega, hipFuncAttributeMaxDynamicSharedMemorySize, LDS_BYTES);
    int dev = 0, cus = 0, per_cu = 0;
    hipGetDevice(&dev);
    hipDeviceGetAttribute(&cus, hipDeviceAttributeMultiprocessorCount, dev);
    hipOccupancyMaxActiveBlocksPerMultiprocessor(&per_cu, mega, NTHREADS, LDS_BYTES);
    if (per_cu < 1) per_cu = 1;
    grid_blocks = cus * per_cu;
    if (grid_blocks > 256) grid_blocks = 256;
  }
  Params p{};
  const float* const* in = (const float* const*)d_in;
  p.x = (const float GAS*)in[0]; p.c = (const float GAS*)in[1]; p.ctx = (const float GAS*)in[2]; p.cctx = (const float GAS*)in[3]; p.ada_w = (const float GAS*)in[4]; p.ada_b = (const float GAS*)in[5]; p.norm_pre = (const float GAS*)in[6]; p.norm_post = (const float GAS*)in[7];
  p.s5_w_in = (const float GAS*)in[8]; p.s5_lam_re = (const float GAS*)in[9]; p.s5_lam_im = (const float GAS*)in[10]; p.s5_log_dt = (const float GAS*)in[11]; p.s5_b_re = (const float GAS*)in[12]; p.s5_b_im = (const float GAS*)in[13];
  p.s5_c_re = (const float GAS*)in[14]; p.s5_c_im = (const float GAS*)in[15]; p.s5_d = (const float GAS*)in[16]; p.s5_w_glu = (const float GAS*)in[17]; p.s5_b_glu = (const float GAS*)in[18]; p.s5_w_out = (const float GAS*)in[19];
  p.hgrn_w_in = (const float GAS*)in[20]; p.hgrn_lb = (const float GAS*)in[21]; p.hgrn_norm = (const float GAS*)in[22]; p.hgrn_w_out = (const float GAS*)in[23];
  p.out = (float GAS*)d_out; p.ws = (unsigned char GAS*)d_ws;
#if COOP
  int lo = 0, hi = NPHASES;
  void* args[] = {&p, &lo, &hi};
  hipError_t e = hipLaunchCooperativeKernel((void*)mega, dim3(grid_blocks), dim3(NTHREADS), args, LDS_BYTES, stream);
  if (e != hipSuccess) fprintf(stderr, "cooperative launch failed: %s (grid %d)\n", hipGetErrorString(e), grid_blocks);
#else
  for (int ph = 0; ph < NPHASES; ++ph) {
    hipLaunchKernelGGL(mega, dim3(grid_blocks), dim3(NTHREADS), LDS_BYTES, stream, p, ph, ph + 1);
  }
#endif
}
```
